# Optimizing an MI355X kernel written in HIP

```python
import math
import jax, jax.numpy as jnp
from jax import lax
import numpy as np

D_MODEL = 2048
BATCH = 1
SEQ = 8192
DEPTH = 4

N_A = DEPTH // 2
N_B = DEPTH - N_A
EPS = 1e-6
D_FF = 4 * D_MODEL

GLA_HEADS = 4
GLA_DK = (D_MODEL // 2) // GLA_HEADS
GLA_DV = D_MODEL // GLA_HEADS
GLA_GATE_RANK = 16
GLA_GATE_TAU = 16.0
GLA_CHUNK = 64
GLA_QK = GLA_HEADS * GLA_DK
GLA_VV = GLA_HEADS * GLA_DV
GLA_IN = 2 * GLA_QK + 2 * GLA_VV + GLA_GATE_RANK

SWA_HEAD_DIM = 64
SWA_Q_HEADS = D_MODEL // SWA_HEAD_DIM
SWA_KV_HEADS = SWA_Q_HEADS // 8
SWA_GROUP = SWA_Q_HEADS // SWA_KV_HEADS
SWA_WINDOW = 128
SWA_BLOCK = 128

kernel_name = "yoco_gla_swa_sink_hybrid"


def rmsnorm(x, g):
    xf = x.astype(jnp.float32)
    y = xf * lax.rsqrt(jnp.mean(xf * xf, axis=-1, keepdims=True) + EPS)
    return (y * g.astype(jnp.float32)).astype(x.dtype)


def sqrelu_mlp(h, w1, w2):
    u = jax.nn.relu(h @ w1)
    return (u * u) @ w2


def gla_mixer(h, w_in, w_g2, b_g, g_o, w_o):
    B, S, _ = h.shape
    H, dk, dv, C = GLA_HEADS, GLA_DK, GLA_DV, GLA_CHUNK
    nC = S // C
    f32 = jnp.float32
    proj = h @ w_in
    q, k, v, r, glr = jnp.split(
        proj, [GLA_QK, 2 * GLA_QK, 2 * GLA_QK + GLA_VV, 2 * GLA_QK + 2 * GLA_VV], axis=-1)
    log_a = jax.nn.log_sigmoid((glr @ w_g2 + b_g).astype(f32)) / GLA_GATE_TAU

    def to_chunks(t, d):
        return t.reshape(B, nC, C, H, d).transpose(1, 0, 3, 2, 4)

    qc = to_chunks(q.astype(f32) * (dk ** -0.5), dk)
    kc = to_chunks(k.astype(f32), dk)
    vc = to_chunks(v.astype(f32), dv)
    bc = jnp.cumsum(to_chunks(log_a, dk), axis=-2)
    causal = jnp.tril(jnp.ones((C, C), dtype=bool))[:, :, None]

    def step(state, inp):
        qi, ki, vi, bi = inp
        o_inter = jnp.einsum('bhcd,bhde->bhce', qi * jnp.exp(bi), state)
        diff = bi[:, :, :, None, :] - bi[:, :, None, :, :]
        decay = jnp.exp(jnp.where(causal, diff, -jnp.inf))
        attn = jnp.einsum('bhid,bhjd,bhijd->bhij', qi, ki, decay)
        o = o_inter + jnp.einsum('bhij,bhje->bhie', attn, vi)
        b_last = bi[:, :, -1:, :]
        k_dec = ki * jnp.exp(b_last - bi)
        state = jnp.exp(b_last[:, :, 0, :])[..., None] * state + \
            jnp.einsum('bhcd,bhce->bhde', k_dec, vi)
        return state, o

    state0 = jnp.zeros((B, H, dk, dv), f32)
    _, oc = lax.scan(step, state0, (qc, kc, vc, bc))
    o = oc.transpose(1, 0, 3, 2, 4).reshape(B, S, H, dv)
    o = rmsnorm(o, g_o)
    o = o * jax.nn.silu(r.astype(f32)).reshape(B, S, H, dv)
    return (o.reshape(B, S, H * dv) @ w_o.astype(f32)).astype(h.dtype)


def shared_kv(h, g_kv, w_k, w_v, g_k):
    B, S, _ = h.shape
    nB = S // SWA_BLOCK
    u = rmsnorm(h, g_kv)
    k = rmsnorm((u @ w_k).reshape(B, S, SWA_KV_HEADS, SWA_HEAD_DIM), g_k)
    v = (u @ w_v).reshape(B, S, SWA_KV_HEADS, SWA_HEAD_DIM)

    def band(t):
        tb = t.reshape(B, nB, SWA_BLOCK, SWA_KV_HEADS, SWA_HEAD_DIM)
        prev = jnp.pad(tb, ((0, 0), (1, 0), (0, 0), (0, 0), (0, 0)))[:, :-1]
        return jnp.concatenate([prev, tb], axis=2)

    return band(k), band(v)


def swa_sink_mixer(h, k_band, v_band, w_q, g_q, sinks, w_o):
    B, S, _ = h.shape
    nB = S // SWA_BLOCK
    q = (h @ w_q).reshape(B, S, SWA_KV_HEADS, SWA_GROUP, SWA_HEAD_DIM)
    q = rmsnorm(q, g_q) * (SWA_HEAD_DIM ** -0.5)
    qb = q.reshape(B, nB, SWA_BLOCK, SWA_KV_HEADS, SWA_GROUP, SWA_HEAD_DIM)
    s = jnp.einsum('bnqkgd,bnjkd->bkgnqj', qb, k_band).astype(jnp.float32)
    qi = jnp.arange(SWA_BLOCK)[:, None]
    kj = jnp.arange(2 * SWA_BLOCK)[None, :]
    rel = qi + SWA_BLOCK - kj
    valid = (rel >= 0) & (rel < SWA_WINDOW)
    first = (jnp.arange(nB)[:, None, None] > 0) | (kj >= SWA_BLOCK)[None]
    mask = valid[None] & first
    s = jnp.where(mask, s, -jnp.inf)
    sink = jnp.broadcast_to(
        sinks.astype(jnp.float32).reshape(1, SWA_KV_HEADS, SWA_GROUP, 1, 1, 1), s.shape[:-1] + (1,))
    p = jax.nn.softmax(jnp.concatenate([s, sink], axis=-1), axis=-1)[..., :-1]
    o = jnp.einsum('bkgnqj,bnjkd->bnqkgd', p.astype(v_band.dtype), v_band)
    return o.reshape(B, S, D_MODEL) @ w_o


def setup_inputs(seed: int = 0) -> dict:
    key = jax.random.key(seed)
    ks = jax.random.split(key, 20)
    n = jax.random.normal
    f = jnp.float32
    D = D_MODEL
    kvw = SWA_KV_HEADS * SWA_HEAD_DIM
    return {
        "x": n(ks[0], (BATCH, SEQ, D), f),
        "norm_mix": 1.0 + 0.02 * n(ks[1], (DEPTH, D), f),
        "norm_mlp": 1.0 + 0.02 * n(ks[2], (DEPTH, D), f),
        "mlp_w1": n(ks[3], (DEPTH, D, D_FF), f) * D ** -0.5,
        "mlp_w2": n(ks[4], (DEPTH, D_FF, D), f) * D_FF ** -0.5,
        "a_w_in": n(ks[5], (N_A, D, GLA_IN), f) * D ** -0.5,
        "a_w_g2": n(ks[6], (N_A, GLA_GATE_RANK, GLA_QK), f) * GLA_GATE_RANK ** -0.5,
        "a_b_g": 0.1 * n(ks[7], (N_A, GLA_QK), f),
        "a_g_o": 1.0 + 0.02 * n(ks[8], (N_A, GLA_DV), f),
        "a_w_o": n(ks[9], (N_A, GLA_VV, D), f) * GLA_VV ** -0.5,
        "kv_norm": 1.0 + 0.02 * n(ks[10], (D,), f),
        "kv_w_k": n(ks[11], (D, kvw), f) * D ** -0.5,
        "kv_w_v": n(ks[12], (D, kvw), f) * D ** -0.5,
        "kv_g_k": 1.0 + 0.02 * n(ks[13], (SWA_HEAD_DIM,), f),
        "b_w_q": n(ks[14], (N_B, D, SWA_Q_HEADS * SWA_HEAD_DIM), f) * D ** -0.5,
        "b_g_q": 1.0 + 0.02 * n(ks[15], (N_B, SWA_HEAD_DIM), f),
        "b_sinks": 0.5 * n(ks[16], (N_B, SWA_Q_HEADS), f),
        "b_w_o": n(ks[17], (N_B, SWA_Q_HEADS * SWA_HEAD_DIM, D), f) * D ** -0.5,
    }


def reference(x, norm_mix, norm_mlp, mlp_w1, mlp_w2, a_w_in, a_w_g2, a_b_g, a_g_o, a_w_o,
              kv_norm, kv_w_k, kv_w_v, kv_g_k, b_w_q, b_g_q, b_sinks, b_w_o):
    h = x
    k_band = None
    v_band = None
    for layer in range(DEPTH):
        u = rmsnorm(h, norm_mix[layer])
        if layer < N_A:
            i = layer
            h = h + gla_mixer(u, a_w_in[i], a_w_g2[i], a_b_g[i], a_g_o[i], a_w_o[i])
        else:
            if layer == N_A:
                k_band, v_band = shared_kv(h, kv_norm, kv_w_k, kv_w_v, kv_g_k)
            j = layer - N_A
            h = h + swa_sink_mixer(u, k_band, v_band, b_w_q[j], b_g_q[j], b_sinks[j], b_w_o[j])
        h = h + sqrelu_mlp(rmsnorm(h, norm_mlp[layer]), mlp_w1[layer], mlp_w2[layer])
    return h
```

```cpp
#include <hip/hip_runtime.h>
#include <hip/hip_cooperative_groups.h>
#include <cstdio>
#include <cstdint>
namespace cg = cooperative_groups;

namespace pg8 {
#define PG8_LAS __attribute__((address_space(3)))
typedef unsigned short bf16_t;
typedef short bf16x8 __attribute__((ext_vector_type(8)));
typedef float f32x4 __attribute__((ext_vector_type(4)));
typedef unsigned u32x4 __attribute__((ext_vector_type(4)));
constexpr int BM = 256, BK = 64, HALF = 128, HTB = HALF * BK * 2, STAGE_BYTES = 8 * HTB, NXCD = 8, WGM = 8;

__host__ __device__ __forceinline__ int lds_byte(int r, int c) { const int st = (r >> 4) * 2 + (c >> 5), rr = r & 15, cc = c & 31, ob = rr * 64 + cc * 2; return st * 1024 + (ob ^ (((ob >> 9) & 1) << 5)); }
__host__ __device__ __forceinline__ void stage_rc(int b, int& R, int& C) { const int st = b / 1024, sb = b % 1024, swz = sb ^ (((sb >> 9) & 1) << 5); R = (st >> 1) * 16 + swz / 64; C = (st & 1) * 32 + (swz % 64) / 2; }
__host__ __device__ __forceinline__ int perm32(int rho) { const int n = rho >> 4, i = rho & 15; return 8 * (i >> 2) + 4 * n + (i & 3); }

struct Unit { int pm, pn; };
struct Gemm { const bf16_t* A; const bf16_t* Bt; int M, N, K; };

struct StaticOrder {
    int nM, nN, nwg, G, c;
    __host__ __device__ void init(int M, int N, int G_, int c_) { nM = M / BM; nN = N / BM; nwg = nM * nN; G = G_; c = c_; }
    __host__ __device__ bool next(int i, Unit& u) const {
        const long L = (long)i * G + c; if (L >= nwg) return false;
        int wgid = (int)L; { const int q = nwg / NXCD, r = nwg % NXCD, xcd = wgid % NXCD, off = wgid / NXCD; wgid = (xcd < r ? xcd * (q + 1) : r * (q + 1) + (xcd - r) * q) + off; }
        const int nig = WGM * nN, gid = wgid / nig, fm = gid * WGM, gsz = (nM - fm) < WGM ? (nM - fm) : WGM;
        u.pm = fm + ((wgid % nig) % gsz); u.pn = (wgid % nig) / gsz; return true;
    }
    __device__ __forceinline__ void a_ready(const Unit&) const {}
    __device__ __forceinline__ void done(const Unit&) const {}
};

__device__ __forceinline__ unsigned cvt_pk_bf16(float lo, float hi) { unsigned r; asm volatile("v_cvt_pk_bf16_f32 %0, %1, %2" : "=v"(r) : "v"(lo), "v"(hi)); return r; }

template <int ACT, bool RS> struct EpiBf16 {
    static constexpr bool PERM = true, AFTER_DRAIN = false;
    bf16_t* O; int ldc; const float* ssq;
    __device__ __forceinline__ void operator()(const f32x4 (&acc)[2][2][4][2], const Unit& u, int wr, int wc, int fr, int fq) const {
        const int row0 = u.pm * BM + wr * 64 + fr; const int col0 = u.pn * BM + wc * 32 + 8 * fq;
#pragma unroll
        for (int ai = 0; ai < 2; ++ai)
#pragma unroll
            for (int m = 0; m < 4; ++m) { const int row = row0 + ai * HALF + m * 16; bf16_t* rowp = O + (size_t)row * ldc + col0;
                float rs = 1.f;
                if (RS) { const f32x4 a = *(const f32x4*)(ssq + (size_t)row * 32 + fq * 8), b = *(const f32x4*)(ssq + (size_t)row * 32 + fq * 8 + 4);
                    float s = ((a.x + a.y) + (a.z + a.w)) + ((b.x + b.y) + (b.z + b.w)); s += __shfl_xor(s, 16); s += __shfl_xor(s, 32);
                    rs = 1.0f / sqrtf(s * (1.0f / 2048.f) + 1e-6f); }
#pragma unroll
                for (int bj = 0; bj < 2; ++bj) { f32x4 v0 = acc[ai][bj][m][0], v1 = acc[ai][bj][m][1];
                    if (RS) { v0 = v0 * rs; v1 = v1 * rs; }
                    if (ACT == 2) {
#pragma unroll
                        for (int e = 0; e < 4; ++e) { float a = fmaxf(v0[e], 0.f), b = fmaxf(v1[e], 0.f); v0[e] = a * a; v1[e] = b * b; } }
                    u32x4 w; w.x = cvt_pk_bf16(v0[0], v0[1]); w.y = cvt_pk_bf16(v0[2], v0[3]); w.z = cvt_pk_bf16(v1[0], v1[1]); w.w = cvt_pk_bf16(v1[2], v1[3]);
                    *(u32x4*)(rowp + bj * HALF) = w; } }
    }
};
template <bool OUT_F32> struct EpiRes {
    static constexpr bool PERM = true, AFTER_DRAIN = false;
    bf16_t* h; float* outf; int ldc; float* ssq; const float* ssq_in;
    __device__ __forceinline__ void operator()(const f32x4 (&acc)[2][2][4][2], const Unit& u, int wr, int wc, int fr, int fq) const {
        const int col0 = u.pn * BM + wc * 32 + 8 * fq;
#pragma unroll
        for (int ai = 0; ai < 2; ++ai) {
            float rs2[4];
#pragma unroll
            for (int m = 0; m < 4; ++m) { rs2[m] = 1.f;
                if (ssq_in) { const int row = u.pm * BM + ai * HALF + wr * 64 + m * 16 + fr;
                    const f32x4 a = *(const f32x4*)(ssq_in + (size_t)row * 32 + fq * 8), b = *(const f32x4*)(ssq_in + (size_t)row * 32 + fq * 8 + 4);
                    float s = ((a.x + a.y) + (a.z + a.w)) + ((b.x + b.y) + (b.z + b.w)); s += __shfl_xor(s, 16); s += __shfl_xor(s, 32);
                    rs2[m] = 1.0f / (s * (1.0f / 2048.f) + 1e-6f); } }
            asm volatile("" : "+v"(rs2[0]), "+v"(rs2[1]), "+v"(rs2[2]), "+v"(rs2[3]) :: "memory");
            u32x4 pre[4][2];
#pragma unroll
            for (int m = 0; m < 4; ++m) { const size_t off = (size_t)(u.pm * BM + ai * HALF + wr * 64 + m * 16 + fr) * ldc + col0;
#pragma unroll
                for (int bj = 0; bj < 2; ++bj) pre[m][bj] = *(const u32x4*)(h + off + bj * HALF); }
#pragma unroll
            for (int m = 0; m < 4; ++m) { const int row = u.pm * BM + ai * HALF + wr * 64 + m * 16 + fr; const size_t off = (size_t)row * ldc + col0; float s = 0.f;
#pragma unroll
                for (int bj = 0; bj < 2; ++bj) { const u32x4 pw = pre[m][bj];
                    const f32x4 b0 = (f32x4){__builtin_bit_cast(float, pw.x << 16), __builtin_bit_cast(float, pw.x & 0xffff0000u), __builtin_bit_cast(float, pw.y << 16), __builtin_bit_cast(float, pw.y & 0xffff0000u)};
                    const f32x4 b1 = (f32x4){__builtin_bit_cast(float, pw.z << 16), __builtin_bit_cast(float, pw.z & 0xffff0000u), __builtin_bit_cast(float, pw.w << 16), __builtin_bit_cast(float, pw.w & 0xffff0000u)};
                    const f32x4 o0 = b0 + acc[ai][bj][m][0] * rs2[m], o1 = b1 + acc[ai][bj][m][1] * rs2[m];
                    if (OUT_F32) { *(f32x4*)(outf + off + bj * HALF) = o0; *(f32x4*)(outf + off + bj * HALF + 4) = o1; }
                    else { s += ((o0.x * o0.x + o0.y * o0.y) + (o0.z * o0.z + o0.w * o0.w)) + ((o1.x * o1.x + o1.y * o1.y) + (o1.z * o1.z + o1.w * o1.w));
                        u32x4 w; w.x = cvt_pk_bf16(o0.x, o0.y); w.y = cvt_pk_bf16(o0.z, o0.w); w.z = cvt_pk_bf16(o1.x, o1.y); w.w = cvt_pk_bf16(o1.z, o1.w); *(u32x4*)(h + off + bj * HALF) = w; } }
                if (!OUT_F32) { s += __shfl_xor(s, 16); s += __shfl_xor(s, 32);
                    if (fq == 0) ssq[(size_t)row * 32 + u.pn * 4 + wc] = s; } }
            asm volatile("" ::: "memory");
        }
    }
};

template <class Epi, class Sched, bool ALIGN_EPI = false, bool SP2 = false>
__device__ __forceinline__ void gemm_phase(PG8_LAS unsigned char* lds, const Gemm g, const Sched& S, const Epi& E) {
    int tid_l = threadIdx.x; asm volatile("" : "+v"(tid_l));
    const int tid = tid_l, wid = __builtin_amdgcn_readfirstlane(tid >> 6), lane = tid & 63, wr = wid >> 2, wc = wid & 3, fr = lane & 15, fq = lane >> 4;
    const int K = g.K, nt = K / BK;
    unsigned voffA[2], voffB[2];
#pragma unroll
    for (int i = 0; i < 2; ++i) { int R, C; stage_rc(tid * 16 + i * 8192, R, C); const int Rb = Epi::PERM ? ((R & ~31) + perm32(R & 31)) : R;
        voffA[i] = (unsigned)(R * K + C) * 2u; voffB[i] = (unsigned)(Rb * K + C) * 2u; }
    const size_t kstep = (size_t)(BK * 2);
    const size_t hstep = (size_t)HALF * K * 2;
    const size_t tstep = 2 * hstep;
    const unsigned ldsw = (unsigned)wid * 1024u;
    const int aoff = lds_byte(wr * 64 + fr, fq * 8), boff = lds_byte(wc * 32 + fr, fq * 8);
#define PG8_SA(b, h) (((b) * 2 + (h)) * HTB)
#define PG8_SB(b, h) ((4 + (b) * 2 + (h)) * HTB)
#define PG8_STAGE(bufoff, gbase, voff) do { _Pragma("unroll") for (int _i = 0; _i < 2; ++_i) \
        __builtin_amdgcn_global_load_lds((const unsigned*)((const char*)(gbase) + (voff)[_i]), (PG8_LAS unsigned*)(lds + (bufoff) + ldsw + _i * 8192), 16, 0, 0); } while (0)
#define PG8_LDA(dst, b, h) do { _Pragma("unroll") for (int m = 0; m < 4; ++m) _Pragma("unroll") for (int k = 0; k < 2; ++k) dst[m][k] = *(const PG8_LAS bf16x8*)(lds + PG8_SA(b, h) + aoff + m * 2048 + k * 1024); } while (0)
#define PG8_LDB(dst, b, h) do { _Pragma("unroll") for (int n = 0; n < 2; ++n) _Pragma("unroll") for (int k = 0; k < 2; ++k) dst[n][k] = *(const PG8_LAS bf16x8*)(lds + PG8_SB(b, h) + boff + n * 2048 + k * 1024); } while (0)
#define PG8_MMA(ai, bj, At, Bt) do { __builtin_amdgcn_s_setprio(1); _Pragma("unroll") for (int m = 0; m < 4; ++m) _Pragma("unroll") for (int n = 0; n < 2; ++n) _Pragma("unroll") for (int k = 0; k < 2; ++k) \
        acc[ai][bj][m][n] = __builtin_amdgcn_mfma_f32_16x16x32_bf16(Bt[n][k], At[m][k], acc[ai][bj][m][n], 0, 0, 0); __builtin_amdgcn_s_setprio(0); } while (0)
#define PG8_WAIT_V(n) asm volatile("s_waitcnt vmcnt(" #n ")" ::: "memory")
#define PG8_WAIT_L(n) asm volatile("s_waitcnt lgkmcnt(" #n ")" ::: "memory")
#define PG8_BAR __builtin_amdgcn_s_barrier()
#define PG8_SCHED __builtin_amdgcn_sched_barrier(0)
    Unit cur, nxt; int ui = 0;
    if (!S.next(0, cur)) return;
    f32x4 acc[2][2][4][2];
#pragma unroll
    for (int a = 0; a < 2; ++a)
#pragma unroll
        for (int b = 0; b < 2; ++b)
#pragma unroll
            for (int m = 0; m < 4; ++m)
#pragma unroll
                for (int n = 0; n < 2; ++n) acc[a][b][m][n] = (f32x4){0.f, 0.f, 0.f, 0.f};
    bf16x8 At[4][2], B0[2][2], B1[2][2];
    const char* cA = (const char*)g.A + (size_t)cur.pm * tstep; const char* cB = (const char*)g.Bt + (size_t)cur.pn * tstep;
    S.a_ready(cur);
    if constexpr (SP2) {
        PG8_STAGE(PG8_SB(0, 0), cB, voffB); PG8_STAGE(PG8_SB(0, 1), cB + hstep, voffB); PG8_STAGE(PG8_SA(0, 0), cA, voffA); PG8_STAGE(PG8_SA(0, 1), cA + hstep, voffA);
        if (wr == 1) PG8_BAR;
        PG8_WAIT_V(2); PG8_BAR;
        PG8_STAGE(PG8_SB(1, 0), cB + kstep, voffB); PG8_STAGE(PG8_SA(1, 0), cA + kstep, voffA); PG8_STAGE(PG8_SB(1, 1), cB + hstep + kstep, voffB);
        PG8_WAIT_V(6); PG8_BAR;
    } else {
        PG8_STAGE(PG8_SB(0, 0), cB, voffB); PG8_STAGE(PG8_SA(0, 0), cA, voffA); PG8_STAGE(PG8_SB(0, 1), cB + hstep, voffB); PG8_STAGE(PG8_SA(0, 1), cA + hstep, voffA);
        if (wr == 1) PG8_BAR;
        PG8_WAIT_V(4); PG8_BAR;
        PG8_STAGE(PG8_SB(1, 0), cB + kstep, voffB); PG8_STAGE(PG8_SA(1, 0), cA + kstep, voffA); PG8_STAGE(PG8_SB(1, 1), cB + hstep + kstep, voffB);
        PG8_WAIT_V(6); PG8_BAR;
    }
    for (;;) {
        const bool has_next = S.next(ui + 1, nxt);
        const char* nA = has_next ? (const char*)g.A + (size_t)nxt.pm * tstep : cA; const char* nB = has_next ? (const char*)g.Bt + (size_t)nxt.pn * tstep : cB;
        for (int t = 0; t < nt; t += 2) {
            const bool last = (t == nt - 2);
            const char* a1 = cA + (size_t)(t + 1) * kstep;
            const char* a2 = last ? nA : cA + (size_t)(t + 2) * kstep; const char* b2 = last ? nB : cB + (size_t)(t + 2) * kstep;
            const char* a3 = a2 + kstep; const char* b3 = b2 + kstep;
            if (last && has_next) S.a_ready(nxt);
            if constexpr (SP2) {
            PG8_LDB(B0, 0, 0); PG8_LDB(B1, 0, 1); PG8_SCHED; PG8_LDA(At, 0, 0); PG8_STAGE(PG8_SA(1, 1), a1 + hstep, voffA);
            PG8_WAIT_V(8); PG8_WAIT_L(0); PG8_BAR; PG8_MMA(0, 0, At, B0); PG8_MMA(0, 1, At, B1); PG8_BAR; PG8_SCHED;
            PG8_LDA(At, 0, 1); PG8_STAGE(PG8_SB(0, 0), b2, voffB); PG8_STAGE(PG8_SB(0, 1), b2 + hstep, voffB); PG8_STAGE(PG8_SA(0, 0), a2, voffA);
            PG8_WAIT_V(8); PG8_WAIT_L(0); PG8_BAR; PG8_MMA(1, 0, At, B0); PG8_MMA(1, 1, At, B1); PG8_BAR; PG8_SCHED;
            PG8_LDB(B0, 1, 0); PG8_LDB(B1, 1, 1); PG8_SCHED; PG8_LDA(At, 1, 0); PG8_STAGE(PG8_SA(0, 1), a2 + hstep, voffA);
            PG8_WAIT_V(8); PG8_WAIT_L(0); PG8_BAR; PG8_MMA(0, 0, At, B0); PG8_MMA(0, 1, At, B1); PG8_BAR; PG8_SCHED;
            PG8_LDA(At, 1, 1); PG8_STAGE(PG8_SB(1, 0), b3, voffB); PG8_STAGE(PG8_SB(1, 1), b3 + hstep, voffB); PG8_STAGE(PG8_SA(1, 0), a3, voffA);
            PG8_WAIT_V(8); PG8_WAIT_L(0); PG8_BAR; PG8_MMA(1, 0, At, B0); PG8_MMA(1, 1, At, B1); PG8_BAR; PG8_SCHED;
            } else {
            PG8_LDB(B0, 0, 0); PG8_SCHED; PG8_LDA(At, 0, 0); PG8_STAGE(PG8_SA(1, 1), a1 + hstep, voffA);
            PG8_WAIT_L(8); PG8_BAR; PG8_WAIT_L(0); PG8_MMA(0, 0, At, B0); PG8_BAR; PG8_SCHED;
            PG8_LDB(B1, 0, 1); PG8_STAGE(PG8_SB(0, 0), b2, voffB);
            PG8_BAR; PG8_WAIT_L(0); PG8_MMA(0, 1, At, B1); PG8_BAR;
            PG8_LDA(At, 0, 1); PG8_STAGE(PG8_SA(0, 0), a2, voffA);
            PG8_BAR; PG8_WAIT_L(0); PG8_MMA(1, 0, At, B0); PG8_BAR; PG8_SCHED;
            PG8_STAGE(PG8_SB(0, 1), b2 + hstep, voffB);
            PG8_WAIT_V(6); PG8_BAR; PG8_MMA(1, 1, At, B1); PG8_BAR;
            PG8_LDB(B0, 1, 0); PG8_SCHED; PG8_LDA(At, 1, 0); PG8_STAGE(PG8_SA(0, 1), a2 + hstep, voffA);
            PG8_WAIT_L(8); PG8_BAR; PG8_WAIT_L(0); PG8_MMA(0, 0, At, B0); PG8_BAR; PG8_SCHED;
            PG8_LDB(B1, 1, 1); PG8_STAGE(PG8_SB(1, 0), b3, voffB);
            PG8_BAR; PG8_WAIT_L(0); PG8_MMA(0, 1, At, B1); PG8_BAR;
            PG8_LDA(At, 1, 1); PG8_STAGE(PG8_SA(1, 0), a3, voffA);
            PG8_BAR; PG8_WAIT_L(0); PG8_MMA(1, 0, At, B0); PG8_BAR; PG8_SCHED;
            PG8_STAGE(PG8_SB(1, 1), b3 + hstep, voffB);
            PG8_WAIT_V(6); PG8_BAR; PG8_MMA(1, 1, At, B1); PG8_BAR;
            }
        }
        if constexpr (ALIGN_EPI) { if (wr == 0) PG8_BAR; }
        if constexpr (!Epi::AFTER_DRAIN) { E(acc, cur, wr, wc, fr, fq); S.done(cur); }
        if (!has_next) break;
#pragma unroll
        for (int a = 0; a < 2; ++a)
#pragma unroll
            for (int b = 0; b < 2; ++b)
#pragma unroll
                for (int m = 0; m < 4; ++m)
#pragma unroll
                    for (int n = 0; n < 2; ++n) acc[a][b][m][n] = (f32x4){0.f, 0.f, 0.f, 0.f};
        cur = nxt; cA = nA; cB = nB; ++ui;
        if constexpr (ALIGN_EPI) { if (wr == 1) PG8_BAR; }
    }
    PG8_WAIT_V(0);
    if constexpr (!ALIGN_EPI) { if (wr == 0) PG8_BAR; }
    PG8_BAR;
#undef PG8_SA
#undef PG8_SB
#undef PG8_STAGE
#undef PG8_LDA
#undef PG8_LDB
#undef PG8_MMA
#undef PG8_WAIT_V
#undef PG8_WAIT_L
#undef PG8_BAR
#undef PG8_SCHED
}
}

#define LAS __attribute__((address_space(3)))
typedef unsigned short bf16;
typedef unsigned v4u __attribute__((ext_vector_type(4)));
typedef unsigned v2u __attribute__((ext_vector_type(2)));
typedef float f32x4 __attribute__((ext_vector_type(4)));
typedef float f32x16 __attribute__((ext_vector_type(16)));
typedef short bf16x8 __attribute__((ext_vector_type(8)));

constexpr int SEQ = 8192, DM = 2048, FF = 8192, NPROJ = 6144, GIN = 6160, NWAVES = 8, NTHR = 512;
constexpr float EPS = 1e-6f, LOG2E = 1.4426950408889634f;
constexpr size_t MiB = 1u << 20;
constexpr size_t WS_W1T = 16 * MiB, WS_W2T = 144 * MiB, WS_WINT = 272 * MiB, WS_WOAT = 320 * MiB, WS_WKVT = 336 * MiB, WS_WQT = 340 * MiB, WS_WOBT = 356 * MiB;
constexpr size_t WS_XN = 372 * MiB, WS_UN = 404 * MiB, WS_HB = 436 * MiB, WS_PROJ = 436 * MiB, WS_QB = 436 * MiB, WS_OB = 468 * MiB, WS_KVB = 564 * MiB, WS_Y = 580 * MiB;
constexpr size_t WS_GLR = 612 * MiB, WS_QT = 614 * MiB, WS_KTT = 630 * MiB, WS_VT = 646 * MiB, WS_G = 678 * MiB, WS_AG = 680 * MiB, WS_SLOC = 684 * MiB, WS_SINIT = 716 * MiB, WS_OG = 748 * MiB, WS_END = 813 * MiB;
constexpr int LDS_BYTES = 147456;

__device__ __forceinline__ unsigned f2bf(float f) { unsigned u = __builtin_bit_cast(unsigned, f); return (u + 0x7fffu + ((u >> 16) & 1u)) >> 16; }
typedef float f32x2_t __attribute__((ext_vector_type(2))); typedef __bf16 bf16x2_t __attribute__((ext_vector_type(2)));
__device__ __forceinline__ unsigned pk2(float lo, float hi) { f32x2_t v = {lo, hi}; bf16x2_t b = __builtin_convertvector(v, bf16x2_t); return __builtin_bit_cast(unsigned, b); }
__device__ __forceinline__ float bflo(unsigned w) { return __builtin_bit_cast(float, w << 16); }
__device__ __forceinline__ float bfhi(unsigned w) { return __builtin_bit_cast(float, w & 0xffff0000u); }
__device__ __forceinline__ float bf2f(bf16 b) { return __builtin_bit_cast(float, ((unsigned)b) << 16); }
__device__ __forceinline__ float wave_sum(float v) {
#pragma unroll
    for (int o = 1; o < 64; o <<= 1) v += __shfl_xor(v, o);
    return v;
}
__device__ __forceinline__ int crow(int r, int hi) { return (r & 3) + 8 * (r >> 2) + 4 * hi; }
__device__ __forceinline__ int swap23(int x) { return (x & ~12) | ((x & 4) << 1) | ((x & 8) >> 1); }
#define LDS_WAIT() asm volatile("s_waitcnt lgkmcnt(0)" ::: "memory")
#define MFMA32(a, b, c) __builtin_amdgcn_mfma_f32_32x32x16_bf16((a), (b), (c), 0, 0, 0)
__device__ __forceinline__ bf16x8 pack8(float a0, float a1, float a2, float a3, float a4, float a5, float a6, float a7) {
    v4u w; w.x = pg8::cvt_pk_bf16(a0, a1); w.y = pg8::cvt_pk_bf16(a2, a3); w.z = pg8::cvt_pk_bf16(a4, a5); w.w = pg8::cvt_pk_bf16(a6, a7); return __builtin_bit_cast(bf16x8, w);
}

struct Params { const float* in[18]; float* out; unsigned char* ws; };

#define XB_TMO      128
#define XB_XCNT(j)  (256  + 64 * (j))
#define XB_XSUB(j)  (1280 + 64 * (j))
#define XB_XGEN(j)  (2304 + 64 * (j))
#define XB_TOP      3328
#define XB_TOPGEN   3392
#define XCD_BAR_WORDS 3456
#define XB_SPIN_CAP (1u << 18)
__device__ __forceinline__ unsigned xb_ld(unsigned* p)              { return __hip_atomic_load(p, __ATOMIC_RELAXED, __HIP_MEMORY_SCOPE_AGENT); }
__device__ __forceinline__ unsigned xb_add(unsigned* p, unsigned v) { return __hip_atomic_fetch_add(p, v, __ATOMIC_RELAXED, __HIP_MEMORY_SCOPE_AGENT); }
__device__ __forceinline__ unsigned xb_xcc_id() { return (unsigned)__builtin_amdgcn_s_getreg((3 << 11) | 20) & 0xFu; }
#define XB_SPIN(cond, bar) do { unsigned _sp = 0; while (cond) { __builtin_amdgcn_s_sleep(1); \
    if ((++_sp & 255u) == 0u) { if (xb_ld(&(bar)[XB_TMO])) break; if (_sp > XB_SPIN_CAP) { atomicAdd(&(bar)[XB_TMO], 1u); break; } } } } while (0)
struct XcdBarrier { unsigned* bar; unsigned x; volatile LAS unsigned* st; };
__device__ __forceinline__ XcdBarrier xcd_barrier_post(unsigned* bar, volatile LAS unsigned* st) {
    XcdBarrier b; b.bar = bar; b.x = xb_xcc_id(); b.st = st;
    if (threadIdx.x == 0) (void)xb_add(&bar[XB_XCNT(b.x)], 1u);
    return b;
}
__device__ __forceinline__ void xcd_barrier_complete(unsigned* bar, unsigned x, unsigned& nloc, unsigned& nx) {
    const unsigned G = gridDim.x * gridDim.y * gridDim.z;
    unsigned sum, cnt, mine, sp = 0u;
    for (;;) {
        sum = 0u; cnt = 0u; mine = 0u;
#pragma unroll
        for (unsigned j = 0; j < 16; ++j) { const unsigned c = xb_ld(&bar[XB_XCNT(j)]); sum += c; cnt += (c > 0u) ? 1u : 0u; mine = (j == x) ? c : mine; }
        if (sum == G) break;
        __builtin_amdgcn_s_sleep(1);
        if ((++sp & 255u) == 0u) { if (xb_ld(&bar[XB_TMO])) break; if (sp > XB_SPIN_CAP) { atomicAdd(&bar[XB_TMO], 1u); break; } }
    }
    nloc = mine > 0u ? mine : 1u; nx = cnt > 0u ? cnt : 1u;
}
__device__ __forceinline__ void xcd_barrier(const XcdBarrier& b) {
    asm volatile("s_waitcnt vmcnt(0)" ::: "memory");
    __syncthreads();
    int t0_ = threadIdx.x; asm volatile("" : "+v"(t0_));
    if (t0_ == 0) {
        unsigned* bar = b.bar;
        __builtin_amdgcn_s_waitcnt(0);
        unsigned nloc = b.st[0], nx = b.st[1];
        if (nloc == 0u) { xcd_barrier_complete(bar, b.x, nloc, nx); b.st[0] = nloc; b.st[1] = nx; }
        const unsigned old = xb_add(&bar[XB_XSUB(b.x)], 1u);
        const unsigned gen = old / nloc;
        if (old + 1u == (gen + 1u) * nloc) {
            __builtin_amdgcn_fence(__ATOMIC_RELEASE, "agent");
            asm volatile("s_waitcnt vmcnt(0)" ::: "memory");
            const unsigned og = xb_add(&bar[XB_TOP], 1u);
            const unsigned tg = og / nx;
            if (og + 1u == (tg + 1u) * nx) xb_add(&bar[XB_TOPGEN], 1u);
            else XB_SPIN(xb_ld(&bar[XB_TOPGEN]) == tg, bar);
            __builtin_amdgcn_fence(__ATOMIC_ACQUIRE, "agent");
            xb_add(&bar[XB_XGEN(b.x)], 1u);
            asm volatile("s_waitcnt vmcnt(0)" ::: "memory");
        } else {
            XB_SPIN(xb_ld(&bar[XB_XGEN(b.x)]) == gen, bar);
            __builtin_amdgcn_fence(__ATOMIC_ACQUIRE, "agent");
            asm volatile("s_waitcnt vmcnt(0)" ::: "memory");
        }
    }
    __syncthreads();
}


__device__ __forceinline__ void transpose_item(const float* W, int ldw, int K, int nblk, bf16* WT, int row_off, LAS float* scr, int item, int lane, const float* gain = nullptr) {
    const int kb = item / nblk, nb = item % nblk, k0 = 64 * kb, n0 = 32 * nb;
    float wv[32];
    { const float* wp = W + (size_t)(k0 + (lane >> 5)) * ldw + n0 + (lane & 31);
#pragma unroll
      for (int i = 0; i < 32; ++i) wv[i] = wp[(size_t)(2 * i) * ldw]; }
#pragma unroll
    for (int i = 0; i < 32; ++i) scr[(2 * i + (lane >> 5)) * 33 + (lane & 31)] = wv[i];
    LDS_WAIT(); asm volatile("" ::: "memory");
    const int c = lane & 7;
    f32x4 ga = (f32x4){1.f, 1.f, 1.f, 1.f}, gb = ga;
    if (gain) { ga = *(const f32x4*)(gain + k0 + 8 * c); gb = *(const f32x4*)(gain + k0 + 8 * c + 4); }
#pragma unroll
    for (int j = 0; j < 4; ++j) { const int n = (lane >> 3) + 8 * j; const LAS float* s = scr + (8 * c) * 33 + n;
        v4u o; o.x = pk2(s[0 * 33] * ga.x, s[1 * 33] * ga.y); o.y = pk2(s[2 * 33] * ga.z, s[3 * 33] * ga.w); o.z = pk2(s[4 * 33] * gb.x, s[5 * 33] * gb.y); o.w = pk2(s[6 * 33] * gb.z, s[7 * 33] * gb.w);
        *(v4u*)(WT + (size_t)(row_off + n0 + n) * K + k0 + 8 * c) = o; }
    LDS_WAIT(); asm volatile("" ::: "memory");
}

__device__ __forceinline__ void convert_phase(const Params& p, LAS unsigned char* lds, int gw, int NGW, int wave, int lane) {
    LAS float* scr = (LAS float*)(lds + wave * 16384);
    unsigned char* ws = p.ws;
    constexpr int NITEMS = 32768 + 32768 + 12288 + 4096 + 256 + 256 + 4096 + 4096;
    for (int it = gw; it < NITEMS; it += NGW) {
        int r = it;
        if (r < 32768) { const int l = r >> 13; transpose_item(p.in[3] + (size_t)l * DM * FF, FF, DM, FF / 32, (bf16*)(ws + WS_W1T) + (size_t)l * FF * DM, 0, scr, r & 8191, lane, p.in[2] + l * DM); continue; } r -= 32768;
        if (r < 32768) { const int l = r >> 13; transpose_item(p.in[4] + (size_t)l * FF * DM, DM, FF, DM / 32, (bf16*)(ws + WS_W2T) + (size_t)l * DM * FF, 0, scr, r & 8191, lane); continue; } r -= 32768;
        if (r < 12288) { const int l = r / 6144; transpose_item(p.in[5] + (size_t)l * DM * GIN, GIN, DM, NPROJ / 32, (bf16*)(ws + WS_WINT) + (size_t)l * NPROJ * DM, 0, scr, r % 6144, lane); continue; } r -= 12288;
        if (r < 4096) { const int l = r >> 11; transpose_item(p.in[9] + (size_t)l * DM * DM, DM, DM, DM / 32, (bf16*)(ws + WS_WOAT) + (size_t)l * DM * DM, 0, scr, r & 2047, lane); continue; } r -= 4096;
        if (r < 256) { transpose_item(p.in[11], 256, DM, 8, (bf16*)(ws + WS_WKVT), 0, scr, r, lane, p.in[10]); continue; } r -= 256;
        if (r < 256) { transpose_item(p.in[12], 256, DM, 8, (bf16*)(ws + WS_WKVT), 256, scr, r, lane, p.in[10]); continue; } r -= 256;
        if (r < 4096) { const int l = r >> 11; transpose_item(p.in[14] + (size_t)l * DM * DM, DM, DM, DM / 32, (bf16*)(ws + WS_WQT) + (size_t)l * DM * DM, 0, scr, r & 2047, lane, p.in[1] + (2 + l) * DM); continue; } r -= 4096;
        { const int l = r >> 11; transpose_item(p.in[17] + (size_t)l * DM * DM, DM, DM, DM / 32, (bf16*)(ws + WS_WOBT) + (size_t)l * DM * DM, 0, scr, r & 2047, lane); }
    }
}

template <bool GLRF, bool KVN, bool IN16>
__device__ __forceinline__ void norm_phase(const float* hin, const bf16* hin16, bf16* hraw, const float* g1, bf16* XN, const float* w_in_l, float* GLRo, const float* g2, bf16* UN,
                                           LAS unsigned char* lds, int gw, int NGW, int tid, int lane) {
    LAS bf16* WgB = (LAS bf16*)lds;
    if (GLRF) {
        for (int k = tid; k < DM; k += NTHR) { const f32x4* src = (const f32x4*)(w_in_l + (size_t)k * GIN + NPROJ);
            const f32x4 a = src[0], b = src[1], c = src[2], d = src[3];
            WgB[0 * 2056 + k] = (bf16)f2bf(a.x); WgB[1 * 2056 + k] = (bf16)f2bf(a.y); WgB[2 * 2056 + k] = (bf16)f2bf(a.z); WgB[3 * 2056 + k] = (bf16)f2bf(a.w);
            WgB[4 * 2056 + k] = (bf16)f2bf(b.x); WgB[5 * 2056 + k] = (bf16)f2bf(b.y); WgB[6 * 2056 + k] = (bf16)f2bf(b.z); WgB[7 * 2056 + k] = (bf16)f2bf(b.w);
            WgB[8 * 2056 + k] = (bf16)f2bf(c.x); WgB[9 * 2056 + k] = (bf16)f2bf(c.y); WgB[10 * 2056 + k] = (bf16)f2bf(c.z); WgB[11 * 2056 + k] = (bf16)f2bf(c.w);
            WgB[12 * 2056 + k] = (bf16)f2bf(d.x); WgB[13 * 2056 + k] = (bf16)f2bf(d.y); WgB[14 * 2056 + k] = (bf16)f2bf(d.z); WgB[15 * 2056 + k] = (bf16)f2bf(d.w); }
    }
    for (int row = gw; row < SEQ; row += NGW) {
        f32x4 v[8]; float ss = 0.f;
        if (IN16) { const v2u* xr = (const v2u*)(hin16 + (size_t)row * DM) + lane;
#pragma unroll
            for (int j = 0; j < 8; ++j) { const v2u w = xr[64 * j]; v[j] = (f32x4){bflo(w.x), bfhi(w.x), bflo(w.y), bfhi(w.y)}; }
        } else { const f32x4* xr = (const f32x4*)(hin + (size_t)row * DM) + lane;
#pragma unroll
            for (int j = 0; j < 8; ++j) v[j] = xr[64 * j];
            if (hraw) { v2u* o8 = (v2u*)(hraw + (size_t)row * DM) + lane;
#pragma unroll
                for (int j = 0; j < 8; ++j) { v2u w; w.x = pk2(v[j].x, v[j].y); w.y = pk2(v[j].z, v[j].w); o8[64 * j] = w; } } }
#pragma unroll
        for (int j = 0; j < 8; ++j) ss += (v[j].x * v[j].x + v[j].y * v[j].y) + (v[j].z * v[j].z + v[j].w * v[j].w);
        const float rstd = 1.0f / sqrtf(wave_sum(ss) * (1.0f / DM) + EPS);
        if (KVN) {
            v2u* o8 = (v2u*)(UN + (size_t)row * DM) + lane;
#pragma unroll
            for (int j = 0; j < 8; ++j) { const f32x4 gg = ((const f32x4*)g2)[lane + 64 * j]; const f32x4 y = v[j] * rstd * gg; v2u w; w.x = pk2(y.x, y.y); w.y = pk2(y.z, y.w); o8[64 * j] = w; }
        }
        v2u* o8 = (v2u*)(XN + (size_t)row * DM) + lane;
#pragma unroll
        for (int j = 0; j < 8; ++j) { const f32x4 gg = ((const f32x4*)g1)[lane + 64 * j]; v[j] = v[j] * rstd * gg; v2u w; w.x = pk2(v[j].x, v[j].y); w.y = pk2(v[j].z, v[j].w); o8[64 * j] = w; }
    }
    if (GLRF) {
        __syncthreads();
        const int wave = __builtin_amdgcn_readfirstlane(tid >> 6), r32 = lane & 31, hi = lane >> 5;
        LAS float* P = (LAS float*)(lds + 65792);
        for (int i0 = 0; (long)i0 * NGW < SEQ; i0 += 4) {
            const int rowm = (gw - wave + (r32 >> 2)) + NGW * (i0 + (r32 & 3));
            const bf16* ap = XN + (size_t)(rowm < SEQ ? rowm : 0) * DM + 256 * wave + 8 * hi;
            const LAS bf16* bp = WgB + (r32 & 15) * 2056 + 256 * wave + 8 * hi;
            f32x16 acc;
#pragma unroll
            for (int r = 0; r < 16; ++r) acc[r] = 0.f;
#pragma unroll
            for (int ks = 0; ks < 16; ++ks) { const bf16x8 a = *(const bf16x8*)(ap + 16 * ks); const bf16x8 b = *(const LAS bf16x8*)(bp + 16 * ks); acc = MFMA32(a, b, acc); }
#pragma unroll
            for (int r = 0; r < 16; ++r) P[wave * 1024 + r * 64 + lane] = acc[r];
            __syncthreads();
            { const int m = tid >> 4, n = tid & 15, r = (m & 3) + 4 * (m >> 3), l2 = n + 32 * ((m >> 2) & 1); float s = 0.f;
#pragma unroll
              for (int w = 0; w < 8; ++w) s += P[w * 1024 + r * 64 + l2];
              const int rowo = (gw - wave + (m >> 2)) + NGW * (i0 + (m & 3));
              if (rowo < SEQ) GLRo[(size_t)rowo * 16 + n] = s; }
            __syncthreads();
        }
    }
}

__device__ __forceinline__ void gla_prep_unit(const Params& p, int li, int c, int h, LAS unsigned char* lds, int tid, int wave, int lane) {
    unsigned char* ws = p.ws;
    const bf16* PROJ = (const bf16*)(ws + WS_PROJ);
    const float* GLR = (const float*)(ws + WS_GLR);
    bf16* QT = (bf16*)(ws + WS_QT); bf16* KTT = (bf16*)(ws + WS_KTT); bf16* VT = (bf16*)(ws + WS_VT); bf16* AG = (bf16*)(ws + WS_AG);
    float* G = (float*)(ws + WS_G);
    LAS float* Bl = (LAS float*)lds; LAS bf16* Ql = (LAS bf16*)(lds + 65536); LAS bf16* Kl = (LAS bf16*)(lds + 99328); LAS float* T = (LAS float*)(lds + 133120);
    const int ch = c * 4 + h;
    {
        LAS bf16* Vl = (LAS bf16*)lds;
        if (tid < 256) *((LAS f32x4*)(lds + 135168) + tid) = *((const f32x4*)(GLR + (size_t)c * 64 * 16) + tid);
#pragma unroll
        for (int i = 0; i < 8; ++i) { const int it = tid + 512 * i, r = it >> 6, cg = it & 63;
            *((LAS v4u*)Vl + it) = *(const v4u*)(PROJ + ((size_t)c * 64 + r) * NPROJ + 2048 + h * 512 + 8 * cg); }
        __syncthreads();
#pragma unroll
        for (int i = 0; i < 8; ++i) { const int f = wave + 8 * i;
            const int e = (f >> 2) * 32 + (lane & 31), tok0 = (f & 3) * 16 + 8 * (lane >> 5);
            unsigned short t8[8];
#pragma unroll
            for (int j = 0; j < 8; ++j) t8[j] = Vl[(tok0 + j) * 512 + e];
            v4u o; o.x = t8[0] | ((unsigned)t8[1] << 16); o.y = t8[2] | ((unsigned)t8[3] << 16); o.z = t8[4] | ((unsigned)t8[5] << 16); o.w = t8[6] | ((unsigned)t8[7] << 16);
            *(v4u*)(VT + (size_t)ch * 32768 + (f * 64 + lane) * 8) = o; }
        __syncthreads();
    }
    {
        const int d = tid & 255, hf = wave >> 2, col = h * 256 + d;
        const float* wg2 = p.in[6] + (size_t)li * 16 * 1024; const float bias = p.in[7][li * 1024 + col];
        float w[16];
#pragma unroll
        for (int r = 0; r < 16; ++r) w[r] = wg2[r * 1024 + col];
        float cum = 0.f;
        for (int i = 0; i < 32; ++i) {
            const LAS f32x4* gp = (const LAS f32x4*)(lds + 135168) + (hf * 32 + i) * 4;
            const f32x4 g0 = gp[0], g1 = gp[1], g2 = gp[2], g3 = gp[3];
            float z = bias;
            z += g0.x * w[0] + g0.y * w[1] + g0.z * w[2] + g0.w * w[3]; z += g1.x * w[4] + g1.y * w[5] + g1.z * w[6] + g1.w * w[7];
            z += g2.x * w[8] + g2.y * w[9] + g2.z * w[10] + g2.w * w[11]; z += g3.x * w[12] + g3.y * w[13] + g3.z * w[14] + g3.w * w[15];
            const float ls = fminf(z, 0.f) - __logf(1.0f + __expf(-fabsf(z)));
            cum += ls * 0.0625f;
            Bl[(hf * 32 + i) * 256 + d] = cum;
        }
        T[hf * 256 + d] = cum;
    }
    __syncthreads();
    if (tid < 256) G[ch * 256 + tid] = __expf(T[tid] + T[256 + tid]);
#pragma unroll
    for (int i = 0; i < 4; ++i) {
        const int it = tid + 512 * i, r = it >> 5, dg = it & 31; const size_t row = (size_t)c * 64 + r;
        const v4u q8 = *(const v4u*)(PROJ + row * NPROJ + h * 256 + 8 * dg), k8 = *(const v4u*)(PROJ + row * NPROJ + 1024 + h * 256 + 8 * dg);
        f32x4 b0 = *(const LAS f32x4*)(Bl + r * 256 + 8 * dg), b1 = *(const LAS f32x4*)(Bl + r * 256 + 8 * dg + 4);
        const f32x4 t0a = *(const LAS f32x4*)(T + 8 * dg), t0b = *(const LAS f32x4*)(T + 8 * dg + 4), t1a = *(const LAS f32x4*)(T + 256 + 8 * dg), t1b = *(const LAS f32x4*)(T + 256 + 8 * dg + 4);
        if (r >= 32) { b0 = b0 + t0a; b1 = b1 + t0b; }
        const f32x4 bl0 = t0a + t1a, bl1 = t0b + t1b;
        float Bv[8] = {b0.x, b0.y, b0.z, b0.w, b1.x, b1.y, b1.z, b1.w}, BL[8] = {bl0.x, bl0.y, bl0.z, bl0.w, bl1.x, bl1.y, bl1.z, bl1.w};
        float qv[8] = {bflo(q8.x), bfhi(q8.x), bflo(q8.y), bfhi(q8.y), bflo(q8.z), bfhi(q8.z), bflo(q8.w), bfhi(q8.w)};
        float kv[8] = {bflo(k8.x), bfhi(k8.x), bflo(k8.y), bfhi(k8.y), bflo(k8.z), bfhi(k8.z), bflo(k8.w), bfhi(k8.w)};
        float qt[8], kh[8], kt[8];
#pragma unroll
        for (int j = 0; j < 8; ++j) { qt[j] = qv[j] * 0.0625f * __expf(Bv[j]); kh[j] = kv[j] * __expf(-Bv[j]); kt[j] = kv[j] * __expf(BL[j] - Bv[j]); }
        const int pbase = 16 * (dg >> 1) + 4 * (dg & 1);
        v2u w;
        w.x = pk2(qt[0], qt[1]); w.y = pk2(qt[2], qt[3]); *(LAS v2u*)(Ql + r * 264 + pbase) = w;
        w.x = pk2(qt[4], qt[5]); w.y = pk2(qt[6], qt[7]); *(LAS v2u*)(Ql + r * 264 + pbase + 8) = w;
        w.x = pk2(kh[0], kh[1]); w.y = pk2(kh[2], kh[3]); *(LAS v2u*)(Kl + r * 264 + pbase) = w;
        w.x = pk2(kh[4], kh[5]); w.y = pk2(kh[6], kh[7]); *(LAS v2u*)(Kl + r * 264 + pbase + 8) = w;
        v4u o; o.x = pk2(kt[0], kt[1]); o.y = pk2(kt[2], kt[3]); o.z = pk2(kt[4], kt[5]); o.w = pk2(kt[6], kt[7]);
        *(LAS v4u*)(Bl + r * 256 + 8 * dg) = o;
    }
    __syncthreads();
#pragma unroll
    for (int i = 0; i < 4; ++i) { const int f = wave + 8 * i, ib = f >> 4, kd = f & 15;
        const v4u v = *(const LAS v4u*)(Ql + (32 * ib + (lane & 31)) * 264 + 16 * kd + 8 * (lane >> 5));
        *(v4u*)(QT + (size_t)ch * 16384 + (f * 64 + lane) * 8) = v; }
    { const LAS bf16* Ktl = (const LAS bf16*)lds;
#pragma unroll
      for (int i = 0; i < 4; ++i) { const int f = wave + 8 * i;
        const int d = (f >> 2) * 32 + (lane & 31), tok0 = (f & 3) * 16 + 8 * (lane >> 5);
        unsigned short t8[8];
#pragma unroll
        for (int j = 0; j < 8; ++j) t8[j] = Ktl[(tok0 + j) * 512 + 16 * (d >> 3) + (d & 7)];
        v4u o; o.x = t8[0] | ((unsigned)t8[1] << 16); o.y = t8[2] | ((unsigned)t8[3] << 16); o.z = t8[4] | ((unsigned)t8[5] << 16); o.w = t8[6] | ((unsigned)t8[7] << 16);
        *(v4u*)(KTT + (size_t)ch * 16384 + (f * 64 + lane) * 8) = o; } }
    if (wave < 4) {
        const int ib = wave >> 1, jb = wave & 1, r32 = lane & 31, hi = lane >> 5;
        f32x16 acc;
#pragma unroll
        for (int r = 0; r < 16; ++r) acc[r] = 0.f;
        if (jb <= ib) {
#pragma unroll
            for (int ks = 0; ks < 16; ++ks) {
                const bf16x8 a = *(const LAS bf16x8*)(Ql + (32 * ib + r32) * 264 + 16 * ks + 8 * hi);
                const bf16x8 b = *(const LAS bf16x8*)(Kl + (32 * jb + r32) * 264 + 16 * ks + 8 * hi);
                acc = MFMA32(a, b, acc);
            }
        }
#pragma unroll
        for (int r = 0; r < 16; ++r) { const int i = 32 * ib + crow(r, hi), j = 32 * jb + r32;
            AG[((size_t)ch * 64 + i) * 64 + j] = (bf16)f2bf(j <= i ? acc[r] : 0.f); }
    }
    __syncthreads();
}

#define LBAR() asm volatile("s_waitcnt lgkmcnt(0)\n\ts_barrier" ::: "memory")
__device__ __forceinline__ void gla_state_update_lds(f32x16 (&St)[4], const LAS float* GBl, const LAS bf16* KBl, const bf16x8 (&vfr)[4], int dh, int lane, int hi) {
#pragma unroll
    for (int dt = 0; dt < 4; ++dt)
#pragma unroll
        for (int rg = 0; rg < 4; ++rg) { const f32x4 gv = *(const LAS f32x4*)(GBl + 128 * dh + 32 * dt + 8 * rg + 4 * hi);
            St[dt][4 * rg + 0] *= gv.x; St[dt][4 * rg + 1] *= gv.y; St[dt][4 * rg + 2] *= gv.z; St[dt][4 * rg + 3] *= gv.w; }
#pragma unroll
    for (int ks = 0; ks < 4; ++ks)
#pragma unroll
        for (int dt = 0; dt < 4; ++dt) { const bf16x8 afr = *(const LAS bf16x8*)(KBl + ((((4 * dh + dt) * 4 + ks) * 64) + lane) * 8); St[dt] = MFMA32(afr, vfr[ks], St[dt]); }
}

__device__ __forceinline__ void gla_s1_unit(const Params& p, int s, int h, int sl, LAS unsigned char* lds, int tid, int wave, int lane) {
    unsigned char* ws = p.ws;
    const bf16* KTT = (const bf16*)(ws + WS_KTT); const bf16* VT = (const bf16*)(ws + WS_VT); const float* G = (const float*)(ws + WS_G);
    float* SLOC = (float*)(ws + WS_SLOC);
    const int dh = wave >> 2, eb = wave & 3, r32 = lane & 31, hi = lane >> 5, e0 = 128 * sl + 32 * eb;
    f32x16 St[4];
#pragma unroll
    for (int dt = 0; dt < 4; ++dt)
#pragma unroll
        for (int r = 0; r < 16; ++r) St[dt][r] = 0.f;
    v4u pk[4]; float pg = 0.f, gprod = 1.f;
    { const int ch = (s * 8) * 4 + h; const v4u* kp = (const v4u*)(KTT + (size_t)ch * 16384) + tid;
#pragma unroll
      for (int i = 0; i < 4; ++i) pk[i] = kp[512 * i];
      if (tid < 256) pg = G[(size_t)ch * 256 + tid]; }
    bf16x8 vnx[4];
#pragma unroll
    for (int ks = 0; ks < 4; ++ks) vnx[ks] = *(const bf16x8*)(VT + (size_t)((s * 8) * 4 + h) * 32768 + (((e0 >> 5) * 4 + ks) * 64 + lane) * 8);
#pragma unroll 1
    for (int cc = 0; cc < 8; ++cc) {
        const int ch = (s * 8 + cc) * 4 + h, cur = cc & 1;
        LAS bf16* KBl = (LAS bf16*)(lds + cur * 32768); LAS float* GBl = (LAS float*)(lds + 65536 + cur * 1024);
        gprod *= (tid < 256) ? pg : 1.f;
        bf16x8 vfr[4];
#pragma unroll
        for (int ks = 0; ks < 4; ++ks) vfr[ks] = vnx[ks];
        if (cc < 7) {
#pragma unroll
            for (int ks = 0; ks < 4; ++ks) vnx[ks] = *(const bf16x8*)(VT + (size_t)(ch + 4) * 32768 + (((e0 >> 5) * 4 + ks) * 64 + lane) * 8); }
#pragma unroll
        for (int i = 0; i < 4; ++i) *((LAS v4u*)KBl + tid + 512 * i) = pk[i];
        if (tid < 256) GBl[tid] = pg;
        LBAR();
        if (cc < 7) { const int chn = ch + 4; const v4u* kp = (const v4u*)(KTT + (size_t)chn * 16384) + tid;
#pragma unroll
            for (int i = 0; i < 4; ++i) pk[i] = kp[512 * i];
            if (tid < 256) pg = G[(size_t)chn * 256 + tid]; }
        gla_state_update_lds(St, GBl, KBl, vfr, dh, lane, hi);
    }
#pragma unroll
    for (int dt = 0; dt < 4; ++dt)
#pragma unroll
        for (int r = 0; r < 16; ++r) SLOC[((size_t)(s * 4 + h) * 256 + 128 * dh + 32 * dt + crow(r, hi)) * 512 + e0 + r32] = St[dt][r];
    if (sl == 0 && tid < 256) ((float*)(ws + WS_G + MiB))[(s * 4 + h) * 256 + tid] = gprod;
    LBAR();
}

__device__ __forceinline__ void gla_s2_phase(const Params& p, int gtid) {
    unsigned char* ws = p.ws;
    const float* GSEG = (const float*)(ws + WS_G + MiB); const f32x4* SLOC = (const f32x4*)(ws + WS_SLOC); f32x4* SINIT = (f32x4*)(ws + WS_SINIT);
    const int h = gtid >> 15, d = (gtid >> 7) & 255;
    float gs[15]; f32x4 sl[15];
#pragma unroll
    for (int s = 0; s < 15; ++s) { gs[s] = GSEG[(s * 4 + h) * 256 + d]; sl[s] = SLOC[(size_t)s * 131072 + gtid]; }
    f32x4 cur = (f32x4){0.f, 0.f, 0.f, 0.f};
#pragma unroll
    for (int s = 0; s < 16; ++s) {
        SINIT[(size_t)s * 131072 + gtid] = cur;
        if (s < 15) cur = cur * gs[s] + sl[s];
    }
}

__device__ __forceinline__ void gla_s3_unit(const Params& p, int s, int h, int sl, LAS unsigned char* lds, int tid, int wave, int lane) {
    unsigned char* ws = p.ws;
    const bf16* QT = (const bf16*)(ws + WS_QT); const bf16* KTT = (const bf16*)(ws + WS_KTT); const bf16* VT = (const bf16*)(ws + WS_VT); const bf16* AG = (const bf16*)(ws + WS_AG);
    const float* G = (const float*)(ws + WS_G); const float* SINIT = (const float*)(ws + WS_SINIT); bf16* OG = (bf16*)(ws + WS_OG);
    const int dh = wave >> 2, eb = wave & 3, r32 = lane & 31, hi = lane >> 5, e0 = 128 * sl + 32 * eb;
    LAS bf16* KBl = (LAS bf16*)(lds + 65536); LAS float* X = (LAS float*)(lds + 98304); LAS float* GBl = (LAS float*)(lds + 131072);
    v4u pq[4], pk[4]; float pg = 0.f;
    { const int ch = (s * 8) * 4 + h; const v4u* qp = (const v4u*)(QT + (size_t)ch * 16384) + tid; const v4u* kp = (const v4u*)(KTT + (size_t)ch * 16384) + tid;
#pragma unroll
      for (int i = 0; i < 4; ++i) { pq[i] = qp[512 * i]; pk[i] = kp[512 * i]; }
      if (tid < 256) pg = G[(size_t)ch * 256 + tid]; }
    f32x16 St[4];
#pragma unroll
    for (int dt = 0; dt < 4; ++dt)
#pragma unroll
        for (int r = 0; r < 16; ++r) St[dt][r] = SINIT[((size_t)(s * 4 + h) * 256 + 128 * dh + 32 * dt + crow(r, hi)) * 512 + e0 + r32];
#pragma unroll
    for (int i = 0; i < 4; ++i) *((LAS v4u*)lds + tid + 512 * i) = pq[i];
    LBAR();
#pragma unroll 1
    for (int cc = 0; cc < 8; ++cc) {
        const int c = s * 8 + cc, ch = c * 4 + h, cur = cc & 1;
        const LAS bf16* QBl = (const LAS bf16*)(lds + cur * 32768);
        bf16x8 afr[4], vfr[4];
#pragma unroll
        for (int ks = 0; ks < 4; ++ks) {
            afr[ks] = *(const bf16x8*)(AG + ((size_t)ch * 64 + 32 * dh + r32) * 64 + 16 * ks + 8 * hi);
            vfr[ks] = *(const bf16x8*)(VT + (size_t)ch * 32768 + (((e0 >> 5) * 4 + ks) * 64 + lane) * 8); }
        if (cc < 7) { const v4u* qp = (const v4u*)(QT + (size_t)(ch + 4) * 16384) + tid;
#pragma unroll
            for (int i = 0; i < 4; ++i) pq[i] = qp[512 * i]; }
        f32x16 op0, op1;
#pragma unroll
        for (int r = 0; r < 16; ++r) { op0[r] = 0.f; op1[r] = 0.f; }
#pragma unroll
        for (int dt = 0; dt < 4; ++dt)
#pragma unroll
            for (int ss = 0; ss < 2; ++ss) {
                const bf16x8 sb = pack8(St[dt][8 * ss + 0], St[dt][8 * ss + 1], St[dt][8 * ss + 2], St[dt][8 * ss + 3], St[dt][8 * ss + 4], St[dt][8 * ss + 5], St[dt][8 * ss + 6], St[dt][8 * ss + 7]);
                const LAS bf16* qp = QBl + ((8 * dh + 2 * dt + ss) * 64 + lane) * 8;
                const bf16x8 q0 = *(const LAS bf16x8*)qp; const bf16x8 q1 = *(const LAS bf16x8*)(qp + 16 * 512);
                op0 = MFMA32(q0, sb, op0); op1 = MFMA32(q1, sb, op1);
            }
        f32x16 keep, send;
#pragma unroll
        for (int r = 0; r < 16; ++r) { keep[r] = dh ? op1[r] : op0[r]; send[r] = dh ? op0[r] : op1[r]; }
        { LAS float* xd = X + ((1 - dh) * 4 + eb) * 1024 + lane;
#pragma unroll
          for (int r = 0; r < 16; ++r) xd[r * 64] = send[r]; }
#pragma unroll
        for (int i = 0; i < 4; ++i) *((LAS v4u*)KBl + tid + 512 * i) = pk[i];
        if (tid < 256) GBl[tid] = pg;
        LBAR();
        { const LAS float* xs = X + wave * 1024 + lane;
#pragma unroll
          for (int r = 0; r < 16; ++r) keep[r] += xs[r * 64]; }
        if (cc < 7) { const v4u* kp = (const v4u*)(KTT + (size_t)(ch + 4) * 16384) + tid;
#pragma unroll
            for (int i = 0; i < 4; ++i) pk[i] = kp[512 * i];
            if (tid < 256) pg = G[(size_t)(ch + 4) * 256 + tid]; }
#pragma unroll
        for (int ks = 0; ks < 4; ++ks) keep = MFMA32(afr[ks], vfr[ks], keep);
#pragma unroll
        for (int r = 0; r < 16; ++r) OG[((size_t)c * 64 + 32 * dh + crow(r, hi)) * DM + h * 512 + e0 + r32] = (bf16)f2bf(keep[r]);
        gla_state_update_lds(St, GBl, KBl, vfr, dh, lane, hi);
        if (cc < 7) {
#pragma unroll
            for (int i = 0; i < 4; ++i) *((LAS v4u*)(lds + (cur ^ 1) * 32768) + tid + 512 * i) = pq[i]; }
        LBAR();
    }
}

__device__ __forceinline__ void gla_post_phase(const Params& p, int li, int gw, int NGW, int lane) {
    unsigned char* ws = p.ws;
    const bf16* OG = (const bf16*)(ws + WS_OG); const bf16* PROJ = (const bf16*)(ws + WS_PROJ); bf16* Y = (bf16*)(ws + WS_Y);
    const float* go = p.in[8] + li * 512;
    const f32x4 ga = *(const f32x4*)(go + 8 * lane), gb = *(const f32x4*)(go + 8 * lane + 4);
    for (int row = gw; row < SEQ; row += NGW) {
#pragma unroll
        for (int hh = 0; hh < 4; ++hh) {
            const v4u ow = *(const v4u*)(OG + (size_t)row * DM + hh * 512 + 8 * lane);
            const f32x4 a = (f32x4){bflo(ow.x), bfhi(ow.x), bflo(ow.y), bfhi(ow.y)}, b = (f32x4){bflo(ow.z), bfhi(ow.z), bflo(ow.w), bfhi(ow.w)};
            float ss = (a.x * a.x + a.y * a.y) + (a.z * a.z + a.w * a.w) + (b.x * b.x + b.y * b.y) + (b.z * b.z + b.w * b.w);
            const float rstd = 1.0f / sqrtf(wave_sum(ss) * (1.0f / 512.f) + EPS);
            const v4u rr = *(const v4u*)(PROJ + (size_t)row * NPROJ + 4096 + hh * 512 + 8 * lane);
            float rv[8] = {bflo(rr.x), bfhi(rr.x), bflo(rr.y), bfhi(rr.y), bflo(rr.z), bfhi(rr.z), bflo(rr.w), bfhi(rr.w)};
            float yv[8] = {a.x * ga.x, a.y * ga.y, a.z * ga.z, a.w * ga.w, b.x * gb.x, b.y * gb.y, b.z * gb.z, b.w * gb.w};
#pragma unroll
            for (int k = 0; k < 8; ++k) yv[k] = yv[k] * rstd * (rv[k] * __builtin_amdgcn_rcpf(1.0f + __expf(-rv[k])));
            v4u o; o.x = pk2(yv[0], yv[1]); o.y = pk2(yv[2], yv[3]); o.z = pk2(yv[4], yv[5]); o.w = pk2(yv[6], yv[7]);
            *(v4u*)(Y + (size_t)row * DM + hh * 512 + 8 * lane) = o;
        }
    }
}

__device__ __forceinline__ void attn_unit(const Params& p, int lj, int nb, int kh, LAS unsigned char* lds, int tid, int wave, int lane) {
    unsigned char* ws = p.ws;
    const bf16* Q = (const bf16*)(ws + WS_QB); const bf16* KV = (const bf16*)(ws + WS_KVB); bf16* O = (bf16*)(ws + WS_OB);
    const float* gq = p.in[15] + lj * 64; const float* gk = p.in[13]; const float* sinks = p.in[16] + lj * 32;
    LAS bf16* Kl = (LAS bf16*)lds; LAS bf16* VTl = (LAS bf16*)(lds + 36864);
    {
        const int key = tid >> 1, half = tid & 1; const int grow = 128 * (nb - 1) + key;
        v4u kr[4], vr[4];
        if (grow >= 0) {
            const v4u* kp = (const v4u*)(KV + (size_t)grow * 512 + kh * 64 + 32 * half); const v4u* vp = (const v4u*)(KV + (size_t)grow * 512 + 256 + kh * 64 + 32 * half);
#pragma unroll
            for (int i = 0; i < 4; ++i) { kr[i] = kp[i]; vr[i] = vp[i]; }
        } else {
#pragma unroll
            for (int i = 0; i < 4; ++i) { kr[i] = (v4u){0u, 0u, 0u, 0u}; vr[i] = (v4u){0u, 0u, 0u, 0u}; }
        }
        float kf[32]; float ss = 0.f;
#pragma unroll
        for (int i = 0; i < 4; ++i)
#pragma unroll
            for (int j = 0; j < 4; ++j) { const unsigned w = kr[i][j]; kf[8 * i + 2 * j] = bflo(w); kf[8 * i + 2 * j + 1] = bfhi(w); }
#pragma unroll
        for (int i = 0; i < 32; ++i) ss += kf[i] * kf[i];
        ss += __shfl_xor(ss, 1);
        const float sc = 1.0f / sqrtf(ss * (1.0f / 64.f) + EPS);
#pragma unroll
        for (int i = 0; i < 32; ++i) kf[i] = kf[i] * sc * gk[32 * half + i];
#pragma unroll
        for (int i = 0; i < 4; ++i) { v4u o; o.x = pk2(kf[8 * i], kf[8 * i + 1]); o.y = pk2(kf[8 * i + 2], kf[8 * i + 3]); o.z = pk2(kf[8 * i + 4], kf[8 * i + 5]); o.w = pk2(kf[8 * i + 6], kf[8 * i + 7]);
            *(LAS v4u*)(Kl + key * 72 + 32 * half + 8 * i) = o; }
        const int pos = (key & ~15) | swap23(key & 15);
#pragma unroll
        for (int i = 0; i < 4; ++i)
#pragma unroll
            for (int j = 0; j < 4; ++j) { const unsigned w = vr[i][j];
                VTl[(32 * half + 8 * i + 2 * j) * 264 + pos] = (bf16)(w & 0xffffu); VTl[(32 * half + 8 * i + 2 * j + 1) * 264 + pos] = (bf16)(w >> 16); }
    }
    __syncthreads();
    const int r32 = lane & 31, hi = lane >> 5, qh = kh * 8 + wave;
    const float sink2 = sinks[qh] * LOG2E;
    float gqv[4][8];
#pragma unroll
    for (int ks = 0; ks < 4; ++ks)
#pragma unroll
        for (int j = 0; j < 8; ++j) gqv[ks][j] = gq[16 * ks + 8 * hi + j];
#pragma unroll 1
    for (int qb = 0; qb < 4; ++qb) {
        const size_t row = (size_t)128 * nb + 32 * qb + r32;
        const bf16* qp = Q + row * DM + qh * 64 + 8 * hi;
        float qf[4][8]; float ss = 0.f;
#pragma unroll
        for (int ks = 0; ks < 4; ++ks) { const v4u w = *(const v4u*)(qp + 16 * ks);
#pragma unroll
            for (int j = 0; j < 4; ++j) { qf[ks][2 * j] = bflo(w[j]); qf[ks][2 * j + 1] = bfhi(w[j]); } }
#pragma unroll
        for (int ks = 0; ks < 4; ++ks)
#pragma unroll
            for (int j = 0; j < 8; ++j) ss += qf[ks][j] * qf[ks][j];
        ss += __shfl_xor(ss, 32);
        const float rs = (1.0f / sqrtf(ss * (1.0f / 64.f) + EPS)) * 0.125f * LOG2E;
        bf16x8 qfr[4];
#pragma unroll
        for (int ks = 0; ks < 4; ++ks) qfr[ks] = pack8(qf[ks][0] * rs * gqv[ks][0], qf[ks][1] * rs * gqv[ks][1], qf[ks][2] * rs * gqv[ks][2], qf[ks][3] * rs * gqv[ks][3],
                                                        qf[ks][4] * rs * gqv[ks][4], qf[ks][5] * rs * gqv[ks][5], qf[ks][6] * rs * gqv[ks][6], qf[ks][7] * rs * gqv[ks][7]);
        f32x16 sc[5];
#pragma unroll
        for (int t = 0; t < 5; ++t) {
#pragma unroll
            for (int r = 0; r < 16; ++r) sc[t][r] = 0.f;
#pragma unroll
            for (int ks = 0; ks < 4; ++ks) { const bf16x8 kfr = *(const LAS bf16x8*)(Kl + (32 * (qb + t) + r32) * 72 + 16 * ks + 8 * hi); sc[t] = MFMA32(kfr, qfr[ks], sc[t]); }
        }
        float m = sink2;
#pragma unroll
        for (int t = 0; t < 5; ++t) {
            const bool tile_ok = (nb > 0) || (qb + t >= 4);
#pragma unroll
            for (int r = 0; r < 16; ++r) { const int c = crow(r, hi);
                bool valid = tile_ok;
                if (t == 0) valid = valid && (c > r32);
                if (t == 4) valid = valid && (c <= r32);
                sc[t][r] = valid ? sc[t][r] : -INFINITY; m = fmaxf(m, sc[t][r]); } }
        m = fmaxf(m, __shfl_xor(m, 32));
        float l = 0.f;
#pragma unroll
        for (int t = 0; t < 5; ++t)
#pragma unroll
            for (int r = 0; r < 16; ++r) { const float pe = __builtin_amdgcn_exp2f(sc[t][r] - m); sc[t][r] = pe; l += pe; }
        l += __shfl_xor(l, 32); l += __builtin_amdgcn_exp2f(sink2 - m);
        f32x16 ot0, ot1;
#pragma unroll
        for (int r = 0; r < 16; ++r) { ot0[r] = 0.f; ot1[r] = 0.f; }
#pragma unroll
        for (int t = 0; t < 5; ++t)
#pragma unroll
            for (int s = 0; s < 2; ++s) {
                const bf16x8 pf = pack8(sc[t][8 * s + 0], sc[t][8 * s + 1], sc[t][8 * s + 2], sc[t][8 * s + 3], sc[t][8 * s + 4], sc[t][8 * s + 5], sc[t][8 * s + 6], sc[t][8 * s + 7]);
                const LAS bf16* vp = VTl + r32 * 264 + 32 * (qb + t) + 16 * s + 8 * hi;
                const bf16x8 v0 = *(const LAS bf16x8*)vp; const bf16x8 v1 = *(const LAS bf16x8*)(vp + 32 * 264);
                ot0 = MFMA32(v0, pf, ot0); ot1 = MFMA32(v1, pf, ot1);
            }
        const float inv = 1.0f / l;
        bf16* orow = O + row * DM + qh * 64 + 4 * hi;
#pragma unroll
        for (int rg = 0; rg < 4; ++rg) {
            v2u w0; w0.x = pk2(ot0[4 * rg] * inv, ot0[4 * rg + 1] * inv); w0.y = pk2(ot0[4 * rg + 2] * inv, ot0[4 * rg + 3] * inv); *(v2u*)(orow + 8 * rg) = w0;
            v2u w1; w1.x = pk2(ot1[4 * rg] * inv, ot1[4 * rg + 1] * inv); w1.y = pk2(ot1[4 * rg + 2] * inv, ot1[4 * rg + 3] * inv); *(v2u*)(orow + 32 + 8 * rg) = w1;
        }
    }
    __syncthreads();
}

__global__ void __launch_bounds__(NTHR, 2) yoco_fwd(Params p) {
    __shared__ __attribute__((aligned(16))) unsigned char lds_raw[LDS_BYTES];
    LAS unsigned char* lds = (LAS unsigned char*)lds_raw;
    cg::grid_group grid = cg::this_grid();
#ifndef REP_GLA
#define REP_GLA 1
#endif
#ifndef REP_CONV
#define REP_CONV 1
#endif
#ifndef EXTRA_SYNC
#define EXTRA_SYNC 0
#endif
#ifndef REP_NORM
#define REP_NORM 1
#endif
#ifndef CUT
#define CUT 1000
#endif
#define PHC() do { if (phc++ >= CUT) return; } while (0)
#define PWS() Params q = p; int bxq = blockIdx.x; asm volatile("" : "+s"(q.ws), "+s"(q.out), "+s"(bxq))
#define TIDS() int tid = threadIdx.x; asm volatile("" : "+v"(tid)); const int lane = tid & 63, wave = __builtin_amdgcn_readfirstlane(tid >> 6); const int gw = vcu * NWAVES + wave
    const int G = gridDim.x, bx = blockIdx.x; int phc = 0;
    volatile LAS unsigned* bst = (volatile LAS unsigned*)(lds + LDS_BYTES - 64);
    if (threadIdx.x < 2) bst[threadIdx.x] = 0u;
    __syncthreads();
    const XcdBarrier xbar = xcd_barrier_post((unsigned*)p.ws + 1024, bst);
#define GSYNC() xcd_barrier(xbar)
    const int vcu = (G % 8 == 0) ? (bx % 8) * (G / 8) + bx / 8 : bx;
    const int NGW = G * NWAVES;
    { PHC(); PWS(); TIDS(); convert_phase(q, lds, gw, NGW, wave, lane); }
    __syncthreads();
    { PHC(); PWS(); TIDS(); norm_phase<true, false, false>(q.in[0], nullptr, ((bf16*)(q.ws + WS_UN)), q.in[1], ((bf16*)(q.ws + WS_XN)), q.in[5], ((float*)(q.ws + WS_GLR)), nullptr, nullptr, lds, gw, NGW, tid, lane); }
    GSYNC();
    if (p.ws == nullptr) grid.sync();
#pragma unroll 1
    for (int layer = 0; layer < 4; ++layer) {

        if (layer < 2) {
            if (layer == 1) {
                { PHC(); PWS(); TIDS(); norm_phase<true, false, true>(nullptr, ((const bf16*)(q.ws + WS_UN)), nullptr, q.in[1] + layer * DM, ((bf16*)(q.ws + WS_XN)), q.in[5] + (size_t)layer * DM * GIN, ((float*)(q.ws + WS_GLR)), nullptr, nullptr, lds, gw, NGW, tid, lane); }
                GSYNC();
            }
            { PHC(); PWS(); pg8::Gemm g{((bf16*)(q.ws + WS_XN)), (const bf16*)(q.ws + WS_WINT) + (size_t)layer * NPROJ * DM, SEQ, NPROJ, DM}; pg8::StaticOrder S; S.init(SEQ, NPROJ, G, bxq);
              pg8::EpiBf16<0, false> E{(bf16*)(q.ws + WS_PROJ), NPROJ, nullptr};
              pg8::gemm_phase<pg8::EpiBf16<0, false>, pg8::StaticOrder, true, true>(lds, g, S, E); }
            GSYNC();
            { PHC(); PWS(); TIDS(); (void)gw; for (int u = bxq; u < 512; u += G) gla_prep_unit(q, layer, u >> 2, u & 3, lds, tid, wave, lane); }
            GSYNC();
            { PHC(); PWS(); TIDS(); (void)gw; for (int u = vcu; u < 240; u += G) gla_s1_unit(q, u >> 4, (u >> 2) & 3, u & 3, lds, tid, wave, lane); }
            GSYNC();
            { PHC(); PWS(); TIDS(); (void)gw; (void)lane; for (int gt = bxq * NTHR + tid; gt < 131072; gt += G * NTHR) gla_s2_phase(q, gt); }
            GSYNC();
            { PHC(); PWS(); TIDS(); (void)gw; for (int u = vcu; u < 256; u += G) gla_s3_unit(q, u >> 4, (u >> 2) & 3, u & 3, lds, tid, wave, lane); }
            GSYNC();
            { PHC(); PWS(); TIDS(); gla_post_phase(q, layer, gw, NGW, lane); }
            GSYNC();
            { PHC(); PWS(); pg8::Gemm g{(const bf16*)(q.ws + WS_Y), (const bf16*)(q.ws + WS_WOAT) + (size_t)layer * DM * DM, SEQ, DM, DM}; pg8::StaticOrder S; S.init(SEQ, DM, G, bxq);
              pg8::EpiRes<false> E{((bf16*)(q.ws + WS_UN)), nullptr, DM, ((float*)(q.ws + 613 * MiB)), nullptr};
              pg8::gemm_phase<pg8::EpiRes<false>, pg8::StaticOrder, true, true>(lds, g, S, E); }
            GSYNC();
        } else {
            const int lj = layer - 2;
            { PHC(); PWS(); pg8::Gemm g{((bf16*)(q.ws + WS_UN)), (const bf16*)(q.ws + WS_WQT) + (size_t)lj * DM * DM, SEQ, DM, DM}; pg8::StaticOrder S; S.init(SEQ, DM, G, bxq);
              pg8::EpiBf16<0, false> E{(bf16*)(q.ws + WS_QB), DM, nullptr};
              pg8::gemm_phase<pg8::EpiBf16<0, false>, pg8::StaticOrder, true, true>(lds, g, S, E); }
            if (layer == 2) {
              PHC(); PWS(); pg8::Gemm g{((bf16*)(q.ws + WS_UN)), (const bf16*)(q.ws + WS_WKVT), SEQ, 512, DM}; pg8::StaticOrder S; S.init(SEQ, 512, G, bxq);
              pg8::EpiBf16<0, true> E{(bf16*)(q.ws + WS_KVB), 512, ((float*)(q.ws + 812 * MiB))};
              pg8::gemm_phase<pg8::EpiBf16<0, true>, pg8::StaticOrder, true, true>(lds, g, S, E); }
            GSYNC();
            { PHC(); PWS(); TIDS(); (void)gw; for (int u = vcu; u < 256; u += G) attn_unit(q, lj, u >> 2, u & 3, lds, tid, wave, lane); }
            GSYNC();
            { PHC(); PWS(); pg8::Gemm g{(const bf16*)(q.ws + WS_OB), (const bf16*)(q.ws + WS_WOBT) + (size_t)lj * DM * DM, SEQ, DM, DM}; pg8::StaticOrder S; S.init(SEQ, DM, G, bxq);
              pg8::EpiRes<false> E{((bf16*)(q.ws + WS_UN)), nullptr, DM, ((float*)(q.ws + 613 * MiB)), nullptr};
              pg8::gemm_phase<pg8::EpiRes<false>, pg8::StaticOrder, true, true>(lds, g, S, E); }
            GSYNC();
        }
        { PHC(); PWS(); pg8::Gemm g{((bf16*)(q.ws + WS_UN)), (const bf16*)(q.ws + WS_W1T) + (size_t)layer * FF * DM, SEQ, FF, DM}; pg8::StaticOrder S; S.init(SEQ, FF, G, bxq);
          pg8::EpiBf16<2, false> E{((bf16*)(q.ws + WS_HB)), FF, nullptr};
          pg8::gemm_phase<pg8::EpiBf16<2, false>, pg8::StaticOrder, true, true>(lds, g, S, E); }
        GSYNC();
        if (layer < 3) { PHC(); PWS(); pg8::Gemm g{((bf16*)(q.ws + WS_HB)), (const bf16*)(q.ws + WS_W2T) + (size_t)layer * DM * FF, SEQ, DM, FF}; pg8::StaticOrder S; S.init(SEQ, DM, G, bxq);
          pg8::EpiRes<false> E{((bf16*)(q.ws + WS_UN)), nullptr, DM, ((float*)(q.ws + 812 * MiB)), ((const float*)(q.ws + 613 * MiB))};
          pg8::gemm_phase<pg8::EpiRes<false>, pg8::StaticOrder, true, true>(lds, g, S, E); }
        else { PHC(); PWS(); pg8::Gemm g{((bf16*)(q.ws + WS_HB)), (const bf16*)(q.ws + WS_W2T) + (size_t)layer * DM * FF, SEQ, DM, FF}; pg8::StaticOrder S; S.init(SEQ, DM, G, bxq);
          pg8::EpiRes<true> E{((bf16*)(q.ws + WS_UN)), q.out, DM, nullptr, ((const float*)(q.ws + 613 * MiB))};
          pg8::gemm_phase<pg8::EpiRes<true>, pg8::StaticOrder, true, true>(lds, g, S, E); }
        GSYNC();
    }
}

extern "C" void kernel_launch(void* const* d_in, const int* in_sizes, int n_in, void* d_out, int out_size, void* d_ws, size_t ws_size, hipStream_t stream) {
    static int grid = 0;
    if (grid == 0) {
        if (n_in != 18 || out_size != SEQ * DM || ws_size < WS_END) { fprintf(stderr, "kernel_launch: unexpected shapes (n_in %d out %d ws %zu)\n", n_in, out_size, ws_size); grid = -1; return; }
        int dev = 0, cus = 0, per_cu = 0;
        hipGetDevice(&dev); hipDeviceGetAttribute(&cus, hipDeviceAttributeMultiprocessorCount, dev);
        hipOccupancyMaxActiveBlocksPerMultiprocessor(&per_cu, (const void*)yoco_fwd, NTHR, 0);
        (void)hipGetLastError();
        if (per_cu < 1) per_cu = 1;
        grid = cus;
        if (grid > 256) grid = 256;
    }
    if (grid < 0) return;
    if (hipMemsetAsync(d_ws, 0, 65536, stream) != hipSuccess) { fprintf(stderr, "kernel_launch: memset failed\n"); return; }
    Params p{};
    for (int i = 0; i < 18; ++i) p.in[i] = (const float*)d_in[i];
    p.out = (float*)d_out; p.ws = (unsigned char*)d_ws;
    void* args[] = {&p};
    hipError_t e = hipLaunchCooperativeKernel((const void*)yoco_fwd, dim3(grid), dim3(NTHR), args, 0, stream);
    if (e != hipSuccess) fprintf(stderr, "cooperative launch failed: %s (grid %d)\n", hipGetErrorString(e), grid);
}
```

```cpp
#include <hip/hip_runtime.h>
#include <hip/hip_cooperative_groups.h>
#include <cstdio>
#include <cstdint>
namespace cg = cooperative_groups;

namespace pg8 {
#define PG8_LAS __attribute__((address_space(3)))
typedef unsigned short bf16_t;
typedef short bf16x8 __attribute__((ext_vector_type(8)));
typedef float f32x4 __attribute__((ext_vector_type(4)));
typedef unsigned u32x4 __attribute__((ext_vector_type(4)));
constexpr int BM = 256, BK = 64, HALF = 128, HTB = HALF * BK * 2, STAGE_BYTES = 8 * HTB, NXCD = 8, WGM = 8;

__host__ __device__ __forceinline__ int lds_byte(int r, int c) { const int st = (r >> 4) * 2 + (c >> 5), rr = r & 15, cc = c & 31, ob = rr * 64 + cc * 2; return st * 1024 + (ob ^ (((ob >> 9) & 1) << 5)); }
__host__ __device__ __forceinline__ void stage_rc(int b, int& R, int& C) { const int st = b / 1024, sb = b % 1024, swz = sb ^ (((sb >> 9) & 1) << 5); R = (st >> 1) * 16 + swz / 64; C = (st & 1) * 32 + (swz % 64) / 2; }
__host__ __device__ __forceinline__ int perm32(int rho) { const int n = rho >> 4, i = rho & 15; return 8 * (i >> 2) + 4 * n + (i & 3); }

struct Unit { int pm, pn; };
struct Gemm { const bf16_t* A; const bf16_t* Bt; int M, N, K; };

struct StaticOrder {
    int nM, nN, nwg, G, c;
    __host__ __device__ void init(int M, int N, int G_, int c_) { nM = M / BM; nN = N / BM; nwg = nM * nN; G = G_; c = c_; }
    __host__ __device__ bool next(int i, Unit& u) const {
        const long L = (long)i * G + c; if (L >= nwg) return false;
        int wgid = (int)L; { const int q = nwg / NXCD, r = nwg % NXCD, xcd = wgid % NXCD, off = wgid / NXCD; wgid = (xcd < r ? xcd * (q + 1) : r * (q + 1) + (xcd - r) * q) + off; }
        const int nig = WGM * nN, gid = wgid / nig, fm = gid * WGM, gsz = (nM - fm) < WGM ? (nM - fm) : WGM;
        u.pm = fm + ((wgid % nig) % gsz); u.pn = (wgid % nig) / gsz; return true;
    }
    __device__ __forceinline__ void a_ready(const Unit&) const {}
    __device__ __forceinline__ void done(const Unit&) const {}
};

__device__ __forceinline__ unsigned cvt_pk_bf16(float lo, float hi) { unsigned r; asm volatile("v_cvt_pk_bf16_f32 %0, %1, %2" : "=v"(r) : "v"(lo), "v"(hi)); return r; }

template <int ACT, bool RS> struct EpiBf16 {
    static constexpr bool PERM = true, AFTER_DRAIN = false;
    bf16_t* O; int ldc; const float* ssq;
    __device__ __forceinline__ void operator()(const f32x4 (&acc)[2][2][4][2], const Unit& u, int wr, int wc, int fr, int fq) const {
        const int row0 = u.pm * BM + wr * 64 + fr; const int col0 = u.pn * BM + wc * 32 + 8 * fq;
#pragma unroll
        for (int ai = 0; ai < 2; ++ai)
#pragma unroll
            for (int m = 0; m < 4; ++m) { const int row = row0 + ai * HALF + m * 16; bf16_t* rowp = O + (size_t)row * ldc + col0;
                float rs = 1.f;
                if (RS) { const f32x4 a = *(const f32x4*)(ssq + (size_t)row * 32 + fq * 8), b = *(const f32x4*)(ssq + (size_t)row * 32 + fq * 8 + 4);
                    float s = ((a.x + a.y) + (a.z + a.w)) + ((b.x + b.y) + (b.z + b.w)); s += __shfl_xor(s, 16); s += __shfl_xor(s, 32);
                    rs = 1.0f / sqrtf(s * (1.0f / 2048.f) + 1e-6f); }
#pragma unroll
                for (int bj = 0; bj < 2; ++bj) { f32x4 v0 = acc[ai][bj][m][0], v1 = acc[ai][bj][m][1];
                    if (RS) { v0 = v0 * rs; v1 = v1 * rs; }
                    if (ACT == 2) {
#pragma unroll
                        for (int e = 0; e < 4; ++e) { float a = fmaxf(v0[e], 0.f), b = fmaxf(v1[e], 0.f); v0[e] = a * a; v1[e] = b * b; } }
                    u32x4 w; w.x = cvt_pk_bf16(v0[0], v0[1]); w.y = cvt_pk_bf16(v0[2], v0[3]); w.z = cvt_pk_bf16(v1[0], v1[1]); w.w = cvt_pk_bf16(v1[2], v1[3]);
                    *(u32x4*)(rowp + bj * HALF) = w; } }
    }
};
template <bool OUT_F32> struct EpiRes {
    static constexpr bool PERM = true, AFTER_DRAIN = false;
    bf16_t* h; float* outf; int ldc; float* ssq; const float* ssq_in;
    __device__ __forceinline__ void operator()(const f32x4 (&acc)[2][2][4][2], const Unit& u, int wr, int wc, int fr, int fq) const {
        const int col0 = u.pn * BM + wc * 32 + 8 * fq;
#pragma unroll
        for (int ai = 0; ai < 2; ++ai) {
            float rs2[4];
#pragma unroll
            for (int m = 0; m < 4; ++m) { rs2[m] = 1.f;
                if (ssq_in) { const int row = u.pm * BM + ai * HALF + wr * 64 + m * 16 + fr;
                    const f32x4 a = *(const f32x4*)(ssq_in + (size_t)row * 32 + fq * 8), b = *(const f32x4*)(ssq_in + (size_t)row * 32 + fq * 8 + 4);
                    float s = ((a.x + a.y) + (a.z + a.w)) + ((b.x + b.y) + (b.z + b.w)); s += __shfl_xor(s, 16); s += __shfl_xor(s, 32);
                    rs2[m] = 1.0f / (s * (1.0f / 2048.f) + 1e-6f); } }
            asm volatile("" : "+v"(rs2[0]), "+v"(rs2[1]), "+v"(rs2[2]), "+v"(rs2[3]) :: "memory");
            u32x4 pre[4][2];
#pragma unroll
            for (int m = 0; m < 4; ++m) { const size_t off = (size_t)(u.pm * BM + ai * HALF + wr * 64 + m * 16 + fr) * ldc + col0;
#pragma unroll
                for (int bj = 0; bj < 2; ++bj) pre[m][bj] = *(const u32x4*)(h + off + bj * HALF); }
#pragma unroll
            for (int m = 0; m < 4; ++m) { const int row = u.pm * BM + ai * HALF + wr * 64 + m * 16 + fr; const size_t off = (size_t)row * ldc + col0; float s = 0.f;
#pragma unroll
                for (int bj = 0; bj < 2; ++bj) { const u32x4 pw = pre[m][bj];
                    const f32x4 b0 = (f32x4){__builtin_bit_cast(float, pw.x << 16), __builtin_bit_cast(float, pw.x & 0xffff0000u), __builtin_bit_cast(float, pw.y << 16), __builtin_bit_cast(float, pw.y & 0xffff0000u)};
                    const f32x4 b1 = (f32x4){__builtin_bit_cast(float, pw.z << 16), __builtin_bit_cast(float, pw.z & 0xffff0000u), __builtin_bit_cast(float, pw.w << 16), __builtin_bit_cast(float, pw.w & 0xffff0000u)};
                    const f32x4 o0 = b0 + acc[ai][bj][m][0] * rs2[m], o1 = b1 + acc[ai][bj][m][1] * rs2[m];
                    if (OUT_F32) { *(f32x4*)(outf + off + bj * HALF) = o0; *(f32x4*)(outf + off + bj * HALF + 4) = o1; }
                    else { s += ((o0.x * o0.x + o0.y * o0.y) + (o0.z * o0.z + o0.w * o0.w)) + ((o1.x * o1.x + o1.y * o1.y) + (o1.z * o1.z + o1.w * o1.w));
                        u32x4 w; w.x = cvt_pk_bf16(o0.x, o0.y); w.y = cvt_pk_bf16(o0.z, o0.w); w.z = cvt_pk_bf16(o1.x, o1.y); w.w = cvt_pk_bf16(o1.z, o1.w); *(u32x4*)(h + off + bj * HALF) = w; } }
                if (!OUT_F32) { s += __shfl_xor(s, 16); s += __shfl_xor(s, 32);
                    if (fq == 0) ssq[(size_t)row * 32 + u.pn * 4 + wc] = s; } }
            asm volatile("" ::: "memory");
        }
    }
};

template <class Epi, class Sched, bool ALIGN_EPI = false, bool SP2 = false>
__device__ __forceinline__ void gemm_phase(PG8_LAS unsigned char* lds, const Gemm g, const Sched& S, const Epi& E) {
    int tid_l = threadIdx.x; asm volatile("" : "+v"(tid_l));
    const int tid = tid_l, wid = __builtin_amdgcn_readfirstlane(tid >> 6), lane = tid & 63, wr = wid >> 2, wc = wid & 3, fr = lane & 15, fq = lane >> 4;
    const int K = g.K, nt = K / BK;
    unsigned voffA[2], voffB[2];
#pragma unroll
    for (int i = 0; i < 2; ++i) { int R, C; stage_rc(tid * 16 + i * 8192, R, C); const int Rb = Epi::PERM ? ((R & ~31) + perm32(R & 31)) : R;
        voffA[i] = (unsigned)(R * K + C) * 2u; voffB[i] = (unsigned)(Rb * K + C) * 2u; }
    const size_t kstep = (size_t)(BK * 2);
    const size_t hstep = (size_t)HALF * K * 2;
    const size_t tstep = 2 * hstep;
    const unsigned ldsw = (unsigned)wid * 1024u;
    const int aoff = lds_byte(wr * 64 + fr, fq * 8), boff = lds_byte(wc * 32 + fr, fq * 8);
#define PG8_SA(b, h) (((b) * 2 + (h)) * HTB)
#define PG8_SB(b, h) ((4 + (b) * 2 + (h)) * HTB)
#define PG8_STAGE(bufoff, gbase, voff) do { _Pragma("unroll") for (int _i = 0; _i < 2; ++_i) \
        __builtin_amdgcn_global_load_lds((const unsigned*)((const char*)(gbase) + (voff)[_i]), (PG8_LAS unsigned*)(lds + (bufoff) + ldsw + _i * 8192), 16, 0, 0); } while (0)
#define PG8_LDA(dst, b, h) do { _Pragma("unroll") for (int m = 0; m < 4; ++m) _Pragma("unroll") for (int k = 0; k < 2; ++k) dst[m][k] = *(const PG8_LAS bf16x8*)(lds + PG8_SA(b, h) + aoff + m * 2048 + k * 1024); } while (0)
#define PG8_LDB(dst, b, h) do { _Pragma("unroll") for (int n = 0; n < 2; ++n) _Pragma("unroll") for (int k = 0; k < 2; ++k) dst[n][k] = *(const PG8_LAS bf16x8*)(lds + PG8_SB(b, h) + boff + n * 2048 + k * 1024); } while (0)
#define PG8_MMA(ai, bj, At, Bt) do { __builtin_amdgcn_s_setprio(1); _Pragma("unroll") for (int m = 0; m < 4; ++m) _Pragma("unroll") for (int n = 0; n < 2; ++n) _Pragma("unroll") for (int k = 0; k < 2; ++k) \
        acc[ai][bj][m][n] = __builtin_amdgcn_mfma_f32_16x16x32_bf16(Bt[n][k], At[m][k], acc[ai][bj][m][n], 0, 0, 0); __builtin_amdgcn_s_setprio(0); } while (0)
#define PG8_WAIT_V(n) asm volatile("s_waitcnt vmcnt(" #n ")" ::: "memory")
#define PG8_WAIT_L(n) asm volatile("s_waitcnt lgkmcnt(" #n ")" ::: "memory")
#define PG8_BAR __builtin_amdgcn_s_barrier()
#define PG8_SCHED __builtin_amdgcn_sched_barrier(0)
    Unit cur, nxt; int ui = 0;
    if (!S.next(0, cur)) return;
    f32x4 acc[2][2][4][2];
#pragma unroll
    for (int a = 0; a < 2; ++a)
#pragma unroll
        for (int b = 0; b < 2; ++b)
#pragma unroll
            for (int m = 0; m < 4; ++m)
#pragma unroll
                for (int n = 0; n < 2; ++n) acc[a][b][m][n] = (f32x4){0.f, 0.f, 0.f, 0.f};
    bf16x8 At[4][2], B0[2][2], B1[2][2];
    const char* cA = (const char*)g.A + (size_t)cur.pm * tstep; const char* cB = (const char*)g.Bt + (size_t)cur.pn * tstep;
    S.a_ready(cur);
    if constexpr (SP2) {
        PG8_STAGE(PG8_SB(0, 0), cB, voffB); PG8_STAGE(PG8_SB(0, 1), cB + hstep, voffB); PG8_STAGE(PG8_SA(0, 0), cA, voffA); PG8_STAGE(PG8_SA(0, 1), cA + hstep, voffA);
        if (wr == 1) PG8_BAR;
        PG8_WAIT_V(2); PG8_BAR;
        PG8_STAGE(PG8_SB(1, 0), cB + kstep, voffB); PG8_STAGE(PG8_SA(1, 0), cA + kstep, voffA); PG8_STAGE(PG8_SB(1, 1), cB + hstep + kstep, voffB);
        PG8_WAIT_V(6); PG8_BAR;
    } else {
        PG8_STAGE(PG8_SB(0, 0), cB, voffB); PG8_STAGE(PG8_SA(0, 0), cA, voffA); PG8_STAGE(PG8_SB(0, 1), cB + hstep, voffB); PG8_STAGE(PG8_SA(0, 1), cA + hstep, voffA);
        if (wr == 1) PG8_BAR;
        PG8_WAIT_V(4); PG8_BAR;
        PG8_STAGE(PG8_SB(1, 0), cB + kstep, voffB); PG8_STAGE(PG8_SA(1, 0), cA + kstep, voffA); PG8_STAGE(PG8_SB(1, 1), cB + hstep + kstep, voffB);
        PG8_WAIT_V(6); PG8_BAR;
    }
    for (;;) {
        const bool has_next = S.next(ui + 1, nxt);
        const char* nA = has_next ? (const char*)g.A + (size_t)nxt.pm * tstep : cA; const char* nB = has_next ? (const char*)g.Bt + (size_t)nxt.pn * tstep : cB;
        for (int t = 0; t < nt; t += 2) {
            const bool last = (t == nt - 2);
            const char* a1 = cA + (size_t)(t + 1) * kstep;
            const char* a2 = last ? nA : cA + (size_t)(t + 2) * kstep; const char* b2 = last ? nB : cB + (size_t)(t + 2) * kstep;
            const char* a3 = a2 + kstep; const char* b3 = b2 + kstep;
            if (last && has_next) S.a_ready(nxt);
            if constexpr (SP2) {
            PG8_LDB(B0, 0, 0); PG8_LDB(B1, 0, 1); PG8_SCHED; PG8_LDA(At, 0, 0); PG8_STAGE(PG8_SA(1, 1), a1 + hstep, voffA);
            PG8_WAIT_V(8); PG8_WAIT_L(0); PG8_BAR; PG8_MMA(0, 0, At, B0); PG8_MMA(0, 1, At, B1); PG8_BAR; PG8_SCHED;
            PG8_LDA(At, 0, 1); PG8_STAGE(PG8_SB(0, 0), b2, voffB); PG8_STAGE(PG8_SB(0, 1), b2 + hstep, voffB); PG8_STAGE(PG8_SA(0, 0), a2, voffA);
            PG8_WAIT_V(8); PG8_WAIT_L(0); PG8_BAR; PG8_MMA(1, 0, At, B0); PG8_MMA(1, 1, At, B1); PG8_BAR; PG8_SCHED;
            PG8_LDB(B0, 1, 0); PG8_LDB(B1, 1, 1); PG8_SCHED; PG8_LDA(At, 1, 0); PG8_STAGE(PG8_SA(0, 1), a2 + hstep, voffA);
            PG8_WAIT_V(8); PG8_WAIT_L(0); PG8_BAR; PG8_MMA(0, 0, At, B0); PG8_MMA(0, 1, At, B1); PG8_BAR; PG8_SCHED;
            PG8_LDA(At, 1, 1); PG8_STAGE(PG8_SB(1, 0), b3, voffB); PG8_STAGE(PG8_SB(1, 1), b3 + hstep, voffB); PG8_STAGE(PG8_SA(1, 0), a3, voffA);
            PG8_WAIT_V(8); PG8_WAIT_L(0); PG8_BAR; PG8_MMA(1, 0, At, B0); PG8_MMA(1, 1, At, B1); PG8_BAR; PG8_SCHED;
            } else {
            PG8_LDB(B0, 0, 0); PG8_SCHED; PG8_LDA(At, 0, 0); PG8_STAGE(PG8_SA(1, 1), a1 + hstep, voffA);
            PG8_WAIT_L(8); PG8_BAR; PG8_WAIT_L(0); PG8_MMA(0, 0, At, B0); PG8_BAR; PG8_SCHED;
            PG8_LDB(B1, 0, 1); PG8_STAGE(PG8_SB(0, 0), b2, voffB);
            PG8_BAR; PG8_WAIT_L(0); PG8_MMA(0, 1, At, B1); PG8_BAR;
            PG8_LDA(At, 0, 1); PG8_STAGE(PG8_SA(0, 0), a2, voffA);
            PG8_BAR; PG8_WAIT_L(0); PG8_MMA(1, 0, At, B0); PG8_BAR; PG8_SCHED;
            PG8_STAGE(PG8_SB(0, 1), b2 + hstep, voffB);
            PG8_WAIT_V(6); PG8_BAR; PG8_MMA(1, 1, At, B1); PG8_BAR;
            PG8_LDB(B0, 1, 0); PG8_SCHED; PG8_LDA(At, 1, 0); PG8_STAGE(PG8_SA(0, 1), a2 + hstep, voffA);
            PG8_WAIT_L(8); PG8_BAR; PG8_WAIT_L(0); PG8_MMA(0, 0, At, B0); PG8_BAR; PG8_SCHED;
            PG8_LDB(B1, 1, 1); PG8_STAGE(PG8_SB(1, 0), b3, voffB);
            PG8_BAR; PG8_WAIT_L(0); PG8_MMA(0, 1, At, B1); PG8_BAR;
            PG8_LDA(At, 1, 1); PG8_STAGE(PG8_SA(1, 0), a3, voffA);
            PG8_BAR; PG8_WAIT_L(0); PG8_MMA(1, 0, At, B0); PG8_BAR; PG8_SCHED;
            PG8_STAGE(PG8_SB(1, 1), b3 + hstep, voffB);
            PG8_WAIT_V(6); PG8_BAR; PG8_MMA(1, 1, At, B1); PG8_BAR;
            }
        }
        if constexpr (ALIGN_EPI) { if (wr == 0) PG8_BAR; }
        if constexpr (!Epi::AFTER_DRAIN) { E(acc, cur, wr, wc, fr, fq); S.done(cur); }
        if (!has_next) break;
#pragma unroll
        for (int a = 0; a < 2; ++a)
#pragma unroll
            for (int b = 0; b < 2; ++b)
#pragma unroll
                for (int m = 0; m < 4; ++m)
#pragma unroll
                    for (int n = 0; n < 2; ++n) acc[a][b][m][n] = (f32x4){0.f, 0.f, 0.f, 0.f};
        cur = nxt; cA = nA; cB = nB; ++ui;
        if constexpr (ALIGN_EPI) { if (wr == 1) PG8_BAR; }
    }
    PG8_WAIT_V(0);
    if constexpr (!ALIGN_EPI) { if (wr == 0) PG8_BAR; }
    PG8_BAR;
#undef PG8_SA
#undef PG8_SB
#undef PG8_STAGE
#undef PG8_LDA
#undef PG8_LDB
#undef PG8_MMA
#undef PG8_WAIT_V
#undef PG8_WAIT_L
#undef PG8_BAR
#undef PG8_SCHED
}
}

#define LAS __attribute__((address_space(3)))
typedef unsigned short bf16;
typedef unsigned v4u __attribute__((ext_vector_type(4)));
typedef unsigned v2u __attribute__((ext_vector_type(2)));
typedef float f32x4 __attribute__((ext_vector_type(4)));
typedef float f32x16 __attribute__((ext_vector_type(16)));
typedef short bf16x8 __attribute__((ext_vector_type(8)));

constexpr int SEQ = 8192, DM = 2048, FF = 8192, NPROJ = 6144, GIN = 6160, NWAVES = 8, NTHR = 512;
constexpr float EPS = 1e-6f, LOG2E = 1.4426950408889634f;
constexpr size_t MiB = 1u << 20;
constexpr size_t WS_W1T = 16 * MiB, WS_W2T = 144 * MiB, WS_WINT = 272 * MiB, WS_WOAT = 320 * MiB, WS_WKVT = 336 * MiB, WS_WQT = 340 * MiB, WS_WOBT = 356 * MiB;
constexpr size_t WS_XN = 372 * MiB, WS_UN = 404 * MiB, WS_HB = 436 * MiB, WS_PROJ = 436 * MiB, WS_QB = 436 * MiB, WS_OB = 468 * MiB, WS_KVB = 564 * MiB, WS_Y = 580 * MiB;
constexpr size_t WS_GLR = 612 * MiB, WS_QT = 614 * MiB, WS_KTT = 630 * MiB, WS_VT = 646 * MiB, WS_G = 678 * MiB, WS_AG = 680 * MiB, WS_SLOC = 684 * MiB, WS_SINIT = 716 * MiB, WS_OG = 748 * MiB, WS_END = 813 * MiB;
constexpr int LDS_BYTES = 147456;

__device__ __forceinline__ unsigned f2bf(float f) { unsigned u = __builtin_bit_cast(unsigned, f); return (u + 0x7fffu + ((u >> 16) & 1u)) >> 16; }
typedef float f32x2_t __attribute__((ext_vector_type(2))); typedef __bf16 bf16x2_t __attribute__((ext_vector_type(2)));
__device__ __forceinline__ unsigned pk2(float lo, float hi) { f32x2_t v = {lo, hi}; bf16x2_t b = __builtin_convertvector(v, bf16x2_t); return __builtin_bit_cast(unsigned, b); }
__device__ __forceinline__ float bflo(unsigned w) { return __builtin_bit_cast(float, w << 16); }
__device__ __forceinline__ float bfhi(unsigned w) { return __builtin_bit_cast(float, w & 0xffff0000u); }
__device__ __forceinline__ float bf2f(bf16 b) { return __builtin_bit_cast(float, ((unsigned)b) << 16); }
__device__ __forceinline__ float wave_sum(float v) {
#pragma unroll
    for (int o = 1; o < 64; o <<= 1) v += __shfl_xor(v, o);
    return v;
}
__device__ __forceinline__ int crow(int r, int hi) { return (r & 3) + 8 * (r >> 2) + 4 * hi; }
__device__ __forceinline__ int swap23(int x) { return (x & ~12) | ((x & 4) << 1) | ((x & 8) >> 1); }
#define LDS_WAIT() asm volatile("s_waitcnt lgkmcnt(0)" ::: "memory")
#define MFMA32(a, b, c) __builtin_amdgcn_mfma_f32_32x32x16_bf16((a), (b), (c), 0, 0, 0)
__device__ __forceinline__ bf16x8 pack8(float a0, float a1, float a2, float a3, float a4, float a5, float a6, float a7) {
    v4u w; w.x = pg8::cvt_pk_bf16(a0, a1); w.y = pg8::cvt_pk_bf16(a2, a3); w.z = pg8::cvt_pk_bf16(a4, a5); w.w = pg8::cvt_pk_bf16(a6, a7); return __builtin_bit_cast(bf16x8, w);
}

struct Params { const float* in[18]; float* out; unsigned char* ws; };

#define XB_TMO      128
#define XB_XCNT(j)  (256  + 64 * (j))
#define XB_XSUB(j)  (1280 + 64 * (j))
#define XB_XGEN(j)  (2304 + 64 * (j))
#define XB_TOP      3328
#define XB_TOPGEN   3392
#define XCD_BAR_WORDS 3456
#define XB_SPIN_CAP (1u << 18)
__device__ __forceinline__ unsigned xb_ld(unsigned* p)              { return __hip_atomic_load(p, __ATOMIC_RELAXED, __HIP_MEMORY_SCOPE_AGENT); }
__device__ __forceinline__ unsigned xb_add(unsigned* p, unsigned v) { return __hip_atomic_fetch_add(p, v, __ATOMIC_RELAXED, __HIP_MEMORY_SCOPE_AGENT); }
__device__ __forceinline__ unsigned xb_xcc_id() { return (unsigned)__builtin_amdgcn_s_getreg((3 << 11) | 20) & 0xFu; }
#define XB_SPIN(cond, bar) do { unsigned _sp = 0; while (cond) { __builtin_amdgcn_s_sleep(1); \
    if ((++_sp & 255u) == 0u) { if (xb_ld(&(bar)[XB_TMO])) break; if (_sp > XB_SPIN_CAP) { atomicAdd(&(bar)[XB_TMO], 1u); break; } } } } while (0)
struct XcdBarrier { unsigned* bar; unsigned x; volatile LAS unsigned* st; };
__device__ __forceinline__ XcdBarrier xcd_barrier_post(unsigned* bar, volatile LAS unsigned* st) {
    XcdBarrier b; b.bar = bar; b.x = xb_xcc_id(); b.st = st;
    if (threadIdx.x == 0) (void)xb_add(&bar[XB_XCNT(b.x)], 1u);
    return b;
}
__device__ __forceinline__ void xcd_barrier_complete(unsigned* bar, unsigned x, unsigned& nloc, unsigned& nx) {
    const unsigned G = gridDim.x * gridDim.y * gridDim.z;
    unsigned sum, cnt, mine, sp = 0u;
    for (;;) {
        sum = 0u; cnt = 0u; mine = 0u;
#pragma unroll
        for (unsigned j = 0; j < 16; ++j) { const unsigned c = xb_ld(&bar[XB_XCNT(j)]); sum += c; cnt += (c > 0u) ? 1u : 0u; mine = (j == x) ? c : mine; }
        if (sum == G) break;
        __builtin_amdgcn_s_sleep(1);
        if ((++sp & 255u) == 0u) { if (xb_ld(&bar[XB_TMO])) break; if (sp > XB_SPIN_CAP) { atomicAdd(&bar[XB_TMO], 1u); break; } }
    }
    nloc = mine > 0u ? mine : 1u; nx = cnt > 0u ? cnt : 1u;
}
__device__ __forceinline__ void xcd_barrier(const XcdBarrier& b) {
    asm volatile("s_waitcnt vmcnt(0)" ::: "memory");
    __syncthreads();
    int t0_ = threadIdx.x; asm volatile("" : "+v"(t0_));
    if (t0_ == 0) {
        unsigned* bar = b.bar;
        __builtin_amdgcn_s_waitcnt(0);
        unsigned nloc = b.st[0], nx = b.st[1];
        if (nloc == 0u) { xcd_barrier_complete(bar, b.x, nloc, nx); b.st[0] = nloc; b.st[1] = nx; }
        const unsigned old = xb_add(&bar[XB_XSUB(b.x)], 1u);
        const unsigned gen = old / nloc;
        if (old + 1u == (gen + 1u) * nloc) {
            __builtin_amdgcn_fence(__ATOMIC_RELEASE, "agent");
            asm volatile("s_waitcnt vmcnt(0)" ::: "memory");
            const unsigned og = xb_add(&bar[XB_TOP], 1u);
            const unsigned tg = og / nx;
            if (og + 1u == (tg + 1u) * nx) xb_add(&bar[XB_TOPGEN], 1u);
            else XB_SPIN(xb_ld(&bar[XB_TOPGEN]) == tg, bar);
            __builtin_amdgcn_fence(__ATOMIC_ACQUIRE, "agent");
            xb_add(&bar[XB_XGEN(b.x)], 1u);
            asm volatile("s_waitcnt vmcnt(0)" ::: "memory");
        } else {
            XB_SPIN(xb_ld(&bar[XB_XGEN(b.x)]) == gen, bar);
            __builtin_amdgcn_fence(__ATOMIC_ACQUIRE, "agent");
            asm volatile("s_waitcnt vmcnt(0)" ::: "memory");
        }
    }
    __syncthreads();
}


__device__ __forceinline__ void transpose_item(const float* W, int ldw, int K, int nblk, bf16* WT, int row_off, LAS float* scr, int item, int lane, const float* gain = nullptr) {
    const int kb = item / nblk, nb = item % nblk, k0 = 64 * kb, n0 = 32 * nb;
    float wv[32];
    { const float* wp = W + (size_t)(k0 + (lane >> 5)) * ldw + n0 + (lane & 31);
#pragma unroll
      for (int i = 0; i < 32; ++i) wv[i] = wp[(size_t)(2 * i) * ldw]; }
#pragma unroll
    for (int i = 0; i < 32; ++i) scr[(2 * i + (lane >> 5)) * 33 + (lane & 31)] = wv[i];
    LDS_WAIT(); asm volatile("" ::: "memory");
    const int c = lane & 7;
    f32x4 ga = (f32x4){1.f, 1.f, 1.f, 1.f}, gb = ga;
    if (gain) { ga = *(const f32x4*)(gain + k0 + 8 * c); gb = *(const f32x4*)(gain + k0 + 8 * c + 4); }
#pragma unroll
    for (int j = 0; j < 4; ++j) { const int n = (lane >> 3) + 8 * j; const LAS float* s = scr + (8 * c) * 33 + n;
        v4u o; o.x = pk2(s[0 * 33] * ga.x, s[1 * 33] * ga.y); o.y = pk2(s[2 * 33] * ga.z, s[3 * 33] * ga.w); o.z = pk2(s[4 * 33] * gb.x, s[5 * 33] * gb.y); o.w = pk2(s[6 * 33] * gb.z, s[7 * 33] * gb.w);
        *(v4u*)(WT + (size_t)(row_off + n0 + n) * K + k0 + 8 * c) = o; }
    LDS_WAIT(); asm volatile("" ::: "memory");
}

__device__ __forceinline__ void convert_phase(const Params& p, LAS unsigned char* lds, int gw, int NGW, int wave, int lane) {
    LAS float* scr = (LAS float*)(lds + wave * 16384);
    unsigned char* ws = p.ws;
    constexpr int NITEMS = 32768 + 32768 + 12288 + 4096 + 256 + 256 + 4096 + 4096;
    for (int it = gw; it < NITEMS; it += NGW) {
        int r = it;
        if (r < 32768) { const int l = r >> 13; transpose_item(p.in[3] + (size_t)l * DM * FF, FF, DM, FF / 32, (bf16*)(ws + WS_W1T) + (size_t)l * FF * DM, 0, scr, r & 8191, lane, p.in[2] + l * DM); continue; } r -= 32768;
        if (r < 32768) { const int l = r >> 13; transpose_item(p.in[4] + (size_t)l * FF * DM, DM, FF, DM / 32, (bf16*)(ws + WS_W2T) + (size_t)l * DM * FF, 0, scr, r & 8191, lane); continue; } r -= 32768;
        if (r < 12288) { const int l = r / 6144; transpose_item(p.in[5] + (size_t)l * DM * GIN, GIN, DM, NPROJ / 32, (bf16*)(ws + WS_WINT) + (size_t)l * NPROJ * DM, 0, scr, r % 6144, lane); continue; } r -= 12288;
        if (r < 4096) { const int l = r >> 11; transpose_item(p.in[9] + (size_t)l * DM * DM, DM, DM, DM / 32, (bf16*)(ws + WS_WOAT) + (size_t)l * DM * DM, 0, scr, r & 2047, lane); continue; } r -= 4096;
        if (r < 256) { transpose_item(p.in[11], 256, DM, 8, (bf16*)(ws + WS_WKVT), 0, scr, r, lane, p.in[10]); continue; } r -= 256;
        if (r < 256) { transpose_item(p.in[12], 256, DM, 8, (bf16*)(ws + WS_WKVT), 256, scr, r, lane, p.in[10]); continue; } r -= 256;
        if (r < 4096) { const int l = r >> 11; transpose_item(p.in[14] + (size_t)l * DM * DM, DM, DM, DM / 32, (bf16*)(ws + WS_WQT) + (size_t)l * DM * DM, 0, scr, r & 2047, lane, p.in[1] + (2 + l) * DM); continue; } r -= 4096;
        { const int l = r >> 11; transpose_item(p.in[17] + (size_t)l * DM * DM, DM, DM, DM / 32, (bf16*)(ws + WS_WOBT) + (size_t)l * DM * DM, 0, scr, r & 2047, lane); }
    }
}

template <bool GLRF, bool KVN, bool IN16>
__device__ __forceinline__ void norm_phase(const float* hin, const bf16* hin16, bf16* hraw, const float* g1, bf16* XN, const float* w_in_l, float* GLRo, const float* g2, bf16* UN,
                                           LAS unsigned char* lds, int gw, int NGW, int tid, int lane) {
    LAS bf16* WgB = (LAS bf16*)lds;
    if (GLRF) {
        for (int k = tid; k < DM; k += NTHR) { const f32x4* src = (const f32x4*)(w_in_l + (size_t)k * GIN + NPROJ);
            const f32x4 a = src[0], b = src[1], c = src[2], d = src[3];
            WgB[0 * 2056 + k] = (bf16)f2bf(a.x); WgB[1 * 2056 + k] = (bf16)f2bf(a.y); WgB[2 * 2056 + k] = (bf16)f2bf(a.z); WgB[3 * 2056 + k] = (bf16)f2bf(a.w);
            WgB[4 * 2056 + k] = (bf16)f2bf(b.x); WgB[5 * 2056 + k] = (bf16)f2bf(b.y); WgB[6 * 2056 + k] = (bf16)f2bf(b.z); WgB[7 * 2056 + k] = (bf16)f2bf(b.w);
            WgB[8 * 2056 + k] = (bf16)f2bf(c.x); WgB[9 * 2056 + k] = (bf16)f2bf(c.y); WgB[10 * 2056 + k] = (bf16)f2bf(c.z); WgB[11 * 2056 + k] = (bf16)f2bf(c.w);
            WgB[12 * 2056 + k] = (bf16)f2bf(d.x); WgB[13 * 2056 + k] = (bf16)f2bf(d.y); WgB[14 * 2056 + k] = (bf16)f2bf(d.z); WgB[15 * 2056 + k] = (bf16)f2bf(d.w); }
    }
    for (int row = gw; row < SEQ; row += NGW) {
        f32x4 v[8]; float ss = 0.f;
        if (IN16) { const v2u* xr = (const v2u*)(hin16 + (size_t)row * DM) + lane;
#pragma unroll
            for (int j = 0; j < 8; ++j) { const v2u w = xr[64 * j]; v[j] = (f32x4){bflo(w.x), bfhi(w.x), bflo(w.y), bfhi(w.y)}; }
        } else { const f32x4* xr = (const f32x4*)(hin + (size_t)row * DM) + lane;
#pragma unroll
            for (int j = 0; j < 8; ++j) v[j] = xr[64 * j];
            if (hraw) { v2u* o8 = (v2u*)(hraw + (size_t)row * DM) + lane;
#pragma unroll
                for (int j = 0; j < 8; ++j) { v2u w; w.x = pk2(v[j].x, v[j].y); w.y = pk2(v[j].z, v[j].w); o8[64 * j] = w; } } }
#pragma unroll
        for (int j = 0; j < 8; ++j) ss += (v[j].x * v[j].x + v[j].y * v[j].y) + (v[j].z * v[j].z + v[j].w * v[j].w);
        const float rstd = 1.0f / sqrtf(wave_sum(ss) * (1.0f / DM) + EPS);
        if (KVN) {
            v2u* o8 = (v2u*)(UN + (size_t)row * DM) + lane;
#pragma unroll
            for (int j = 0; j < 8; ++j) { const f32x4 gg = ((const f32x4*)g2)[lane + 64 * j]; const f32x4 y = v[j] * rstd * gg; v2u w; w.x = pk2(y.x, y.y); w.y = pk2(y.z, y.w); o8[64 * j] = w; }
        }
        v2u* o8 = (v2u*)(XN + (size_t)row * DM) + lane;
#pragma unroll
        for (int j = 0; j < 8; ++j) { const f32x4 gg = ((const f32x4*)g1)[lane + 64 * j]; v[j] = v[j] * rstd * gg; v2u w; w.x = pk2(v[j].x, v[j].y); w.y = pk2(v[j].z, v[j].w); o8[64 * j] = w; }
    }
    if (GLRF) {
        __syncthreads();
        const int wave = __builtin_amdgcn_readfirstlane(tid >> 6), r32 = lane & 31, hi = lane >> 5;
        LAS float* P = (LAS float*)(lds + 65792);
        for (int i0 = 0; (long)i0 * NGW < SEQ; i0 += 4) {
            const int rowm = (gw - wave + (r32 >> 2)) + NGW * (i0 + (r32 & 3));
            const bf16* ap = XN + (size_t)(rowm < SEQ ? rowm : 0) * DM + 256 * wave + 8 * hi;
            const LAS bf16* bp = WgB + (r32 & 15) * 2056 + 256 * wave + 8 * hi;
            f32x16 acc;
#pragma unroll
            for (int r = 0; r < 16; ++r) acc[r] = 0.f;
#pragma unroll
            for (int ks = 0; ks < 16; ++ks) { const bf16x8 a = *(const bf16x8*)(ap + 16 * ks); const bf16x8 b = *(const LAS bf16x8*)(bp + 16 * ks); acc = MFMA32(a, b, acc); }
#pragma unroll
            for (int r = 0; r < 16; ++r) P[wave * 1024 + r * 64 + lane] = acc[r];
            __syncthreads();
            { const int m = tid >> 4, n = tid & 15, r = (m & 3) + 4 * (m >> 3), l2 = n + 32 * ((m >> 2) & 1); float s = 0.f;
#pragma unroll
              for (int w = 0; w < 8; ++w) s += P[w * 1024 + r * 64 + l2];
              const int rowo = (gw - wave + (m >> 2)) + NGW * (i0 + (m & 3));
              if (rowo < SEQ) GLRo[(size_t)rowo * 16 + n] = s; }
            __syncthreads();
        }
    }
}

__device__ __forceinline__ void gla_prep_unit(const Params& p, int li, int c, int h, LAS unsigned char* lds, int tid, int wave, int lane) {
    unsigned char* ws = p.ws;
    const bf16* PROJ = (const bf16*)(ws + WS_PROJ);
    const float* GLR = (const float*)(ws + WS_GLR);
    bf16* QT = (bf16*)(ws + WS_QT); bf16* KTT = (bf16*)(ws + WS_KTT); bf16* VT = (bf16*)(ws + WS_VT); bf16* AG = (bf16*)(ws + WS_AG);
    float* G = (float*)(ws + WS_G);
    LAS float* Bl = (LAS float*)lds; LAS bf16* Ql = (LAS bf16*)(lds + 65536); LAS bf16* Kl = (LAS bf16*)(lds + 99328); LAS float* T = (LAS float*)(lds + 133120);
    const int ch = c * 4 + h;
    {
        LAS bf16* Vl = (LAS bf16*)lds;
        if (tid < 256) *((LAS f32x4*)(lds + 135168) + tid) = *((const f32x4*)(GLR + (size_t)c * 64 * 16) + tid);
#pragma unroll
        for (int i = 0; i < 8; ++i) { const int it = tid + 512 * i, r = it >> 6, cg = it & 63;
            *((LAS v4u*)Vl + it) = *(const v4u*)(PROJ + ((size_t)c * 64 + r) * NPROJ + 2048 + h * 512 + 8 * cg); }
        __syncthreads();
#pragma unroll
        for (int i = 0; i < 8; ++i) { const int f = wave + 8 * i;
            const int e = (f >> 2) * 32 + (lane & 31), tok0 = (f & 3) * 16 + 8 * (lane >> 5);
            unsigned short t8[8];
#pragma unroll
            for (int j = 0; j < 8; ++j) t8[j] = Vl[(tok0 + j) * 512 + e];
            v4u o; o.x = t8[0] | ((unsigned)t8[1] << 16); o.y = t8[2] | ((unsigned)t8[3] << 16); o.z = t8[4] | ((unsigned)t8[5] << 16); o.w = t8[6] | ((unsigned)t8[7] << 16);
            *(v4u*)(VT + (size_t)ch * 32768 + (f * 64 + lane) * 8) = o; }
        __syncthreads();
    }
    {
        const int d = tid & 255, hf = wave >> 2, col = h * 256 + d;
        const float* wg2 = p.in[6] + (size_t)li * 16 * 1024; const float bias = p.in[7][li * 1024 + col];
        float w[16];
#pragma unroll
        for (int r = 0; r < 16; ++r) w[r] = wg2[r * 1024 + col];
        float cum = 0.f;
        for (int i = 0; i < 32; ++i) {
            const LAS f32x4* gp = (const LAS f32x4*)(lds + 135168) + (hf * 32 + i) * 4;
            const f32x4 g0 = gp[0], g1 = gp[1], g2 = gp[2], g3 = gp[3];
            float z = bias;
            z += g0.x * w[0] + g0.y * w[1] + g0.z * w[2] + g0.w * w[3]; z += g1.x * w[4] + g1.y * w[5] + g1.z * w[6] + g1.w * w[7];
            z += g2.x * w[8] + g2.y * w[9] + g2.z * w[10] + g2.w * w[11]; z += g3.x * w[12] + g3.y * w[13] + g3.z * w[14] + g3.w * w[15];
            const float ls = fminf(z, 0.f) - __logf(1.0f + __expf(-fabsf(z)));
            cum += ls * 0.0625f;
            Bl[(hf * 32 + i) * 256 + d] = cum;
        }
        T[hf * 256 + d] = cum;
    }
    __syncthreads();
    if (tid < 256) G[ch * 256 + tid] = __expf(T[tid] + T[256 + tid]);
#pragma unroll
    for (int i = 0; i < 4; ++i) {
        const int it = tid + 512 * i, r = it >> 5, dg = it & 31; const size_t row = (size_t)c * 64 + r;
        const v4u q8 = *(const v4u*)(PROJ + row * NPROJ + h * 256 + 8 * dg), k8 = *(const v4u*)(PROJ + row * NPROJ + 1024 + h * 256 + 8 * dg);
        f32x4 b0 = *(const LAS f32x4*)(Bl + r * 256 + 8 * dg), b1 = *(const LAS f32x4*)(Bl + r * 256 + 8 * dg + 4);
        const f32x4 t0a = *(const LAS f32x4*)(T + 8 * dg), t0b = *(const LAS f32x4*)(T + 8 * dg + 4), t1a = *(const LAS f32x4*)(T + 256 + 8 * dg), t1b = *(const LAS f32x4*)(T + 256 + 8 * dg + 4);
        if (r >= 32) { b0 = b0 + t0a; b1 = b1 + t0b; }
        const f32x4 bl0 = t0a + t1a, bl1 = t0b + t1b;
        float Bv[8] = {b0.x, b0.y, b0.z, b0.w, b1.x, b1.y, b1.z, b1.w}, BL[8] = {bl0.x, bl0.y, bl0.z, bl0.w, bl1.x, bl1.y, bl1.z, bl1.w};
        float qv[8] = {bflo(q8.x), bfhi(q8.x), bflo(q8.y), bfhi(q8.y), bflo(q8.z), bfhi(q8.z), bflo(q8.w), bfhi(q8.w)};
        float kv[8] = {bflo(k8.x), bfhi(k8.x), bflo(k8.y), bfhi(k8.y), bflo(k8.z), bfhi(k8.z), bflo(k8.w), bfhi(k8.w)};
        float qt[8], kh[8], kt[8];
#pragma unroll
        for (int j = 0; j < 8; ++j) { qt[j] = qv[j] * 0.0625f * __expf(Bv[j]); kh[j] = kv[j] * __expf(-Bv[j]); kt[j] = kv[j] * __expf(BL[j] - Bv[j]); }
        const int pbase = 16 * (dg >> 1) + 4 * (dg & 1);
        v2u w;
        w.x = pk2(qt[0], qt[1]); w.y = pk2(qt[2], qt[3]); *(LAS v2u*)(Ql + r * 264 + pbase) = w;
        w.x = pk2(qt[4], qt[5]); w.y = pk2(qt[6], qt[7]); *(LAS v2u*)(Ql + r * 264 + pbase + 8) = w;
        w.x = pk2(kh[0], kh[1]); w.y = pk2(kh[2], kh[3]); *(LAS v2u*)(Kl + r * 264 + pbase) = w;
        w.x = pk2(kh[4], kh[5]); w.y = pk2(kh[6], kh[7]); *(LAS v2u*)(Kl + r * 264 + pbase + 8) = w;
        v4u o; o.x = pk2(kt[0], kt[1]); o.y = pk2(kt[2], kt[3]); o.z = pk2(kt[4], kt[5]); o.w = pk2(kt[6], kt[7]);
        *(LAS v4u*)(Bl + r * 256 + 8 * dg) = o;
    }
    __syncthreads();
#pragma unroll
    for (int i = 0; i < 4; ++i) { const int f = wave + 8 * i, ib = f >> 4, kd = f & 15;
        const v4u v = *(const LAS v4u*)(Ql + (32 * ib + (lane & 31)) * 264 + 16 * kd + 8 * (lane >> 5));
        *(v4u*)(QT + (size_t)ch * 16384 + (f * 64 + lane) * 8) = v; }
    { const LAS bf16* Ktl = (const LAS bf16*)lds;
#pragma unroll
      for (int i = 0; i < 4; ++i) { const int f = wave + 8 * i;
        const int d = (f >> 2) * 32 + (lane & 31), tok0 = (f & 3) * 16 + 8 * (lane >> 5);
        unsigned short t8[8];
#pragma unroll
        for (int j = 0; j < 8; ++j) t8[j] = Ktl[(tok0 + j) * 512 + 16 * (d >> 3) + (d & 7)];
        v4u o; o.x = t8[0] | ((unsigned)t8[1] << 16); o.y = t8[2] | ((unsigned)t8[3] << 16); o.z = t8[4] | ((unsigned)t8[5] << 16); o.w = t8[6] | ((unsigned)t8[7] << 16);
        *(v4u*)(KTT + (size_t)ch * 16384 + (f * 64 + lane) * 8) = o; } }
    if (wave < 4) {
        const int ib = wave >> 1, jb = wave & 1, r32 = lane & 31, hi = lane >> 5;
        f32x16 acc;
#pragma unroll
        for (int r = 0; r < 16; ++r) acc[r] = 0.f;
        if (jb <= ib) {
#pragma unroll
            for (int ks = 0; ks < 16; ++ks) {
                const bf16x8 a = *(const LAS bf16x8*)(Ql + (32 * ib + r32) * 264 + 16 * ks + 8 * hi);
                const bf16x8 b = *(const LAS bf16x8*)(Kl + (32 * jb + r32) * 264 + 16 * ks + 8 * hi);
                acc = MFMA32(a, b, acc);
            }
        }
#pragma unroll
        for (int r = 0; r < 16; ++r) { const int i = 32 * ib + crow(r, hi), j = 32 * jb + r32;
            AG[((size_t)ch * 64 + i) * 64 + j] = (bf16)f2bf(j <= i ? acc[r] : 0.f); }
    }
    __syncthreads();
}

#define LBAR() asm volatile("s_waitcnt lgkmcnt(0)\n\ts_barrier" ::: "memory")
__device__ __forceinline__ void gla_state_update_lds(f32x16 (&St)[4], const LAS float* GBl, const LAS bf16* KBl, const bf16x8 (&vfr)[4], int dh, int lane, int hi) {
#pragma unroll
    for (int dt = 0; dt < 4; ++dt)
#pragma unroll
        for (int rg = 0; rg < 4; ++rg) { const f32x4 gv = *(const LAS f32x4*)(GBl + 128 * dh + 32 * dt + 8 * rg + 4 * hi);
            St[dt][4 * rg + 0] *= gv.x; St[dt][4 * rg + 1] *= gv.y; St[dt][4 * rg + 2] *= gv.z; St[dt][4 * rg + 3] *= gv.w; }
#pragma unroll
    for (int ks = 0; ks < 4; ++ks)
#pragma unroll
        for (int dt = 0; dt < 4; ++dt) { const bf16x8 afr = *(const LAS bf16x8*)(KBl + ((((4 * dh + dt) * 4 + ks) * 64) + lane) * 8); St[dt] = MFMA32(afr, vfr[ks], St[dt]); }
}

__device__ __forceinline__ void gla_s1_unit(const Params& p, int s, int h, int sl, LAS unsigned char* lds, int tid, int wave, int lane) {
    unsigned char* ws = p.ws;
    const bf16* KTT = (const bf16*)(ws + WS_KTT); const bf16* VT = (const bf16*)(ws + WS_VT); const float* G = (const float*)(ws + WS_G);
    float* SLOC = (float*)(ws + WS_SLOC);
    const int dh = wave >> 2, eb = wave & 3, r32 = lane & 31, hi = lane >> 5, e0 = 128 * sl + 32 * eb;
    f32x16 St[4];
#pragma unroll
    for (int dt = 0; dt < 4; ++dt)
#pragma unroll
        for (int r = 0; r < 16; ++r) St[dt][r] = 0.f;
    v4u pk[4]; float pg = 0.f, gprod = 1.f;
    { const int ch = (s * 8) * 4 + h; const v4u* kp = (const v4u*)(KTT + (size_t)ch * 16384) + tid;
#pragma unroll
      for (int i = 0; i < 4; ++i) pk[i] = kp[512 * i];
      if (tid < 256) pg = G[(size_t)ch * 256 + tid]; }
    bf16x8 vnx[4];
#pragma unroll
    for (int ks = 0; ks < 4; ++ks) vnx[ks] = *(const bf16x8*)(VT + (size_t)((s * 8) * 4 + h) * 32768 + (((e0 >> 5) * 4 + ks) * 64 + lane) * 8);
#pragma unroll 1
    for (int cc = 0; cc < 8; ++cc) {
        const int ch = (s * 8 + cc) * 4 + h, cur = cc & 1;
        LAS bf16* KBl = (LAS bf16*)(lds + cur * 32768); LAS float* GBl = (LAS float*)(lds + 65536 + cur * 1024);
        gprod *= (tid < 256) ? pg : 1.f;
        bf16x8 vfr[4];
#pragma unroll
        for (int ks = 0; ks < 4; ++ks) vfr[ks] = vnx[ks];
        if (cc < 7) {
#pragma unroll
            for (int ks = 0; ks < 4; ++ks) vnx[ks] = *(const bf16x8*)(VT + (size_t)(ch + 4) * 32768 + (((e0 >> 5) * 4 + ks) * 64 + lane) * 8); }
#pragma unroll
        for (int i = 0; i < 4; ++i) *((LAS v4u*)KBl + tid + 512 * i) = pk[i];
        if (tid < 256) GBl[tid] = pg;
        LBAR();
        if (cc < 7) { const int chn = ch + 4; const v4u* kp = (const v4u*)(KTT + (size_t)chn * 16384) + tid;
#pragma unroll
            for (int i = 0; i < 4; ++i) pk[i] = kp[512 * i];
            if (tid < 256) pg = G[(size_t)chn * 256 + tid]; }
        gla_state_update_lds(St, GBl, KBl, vfr, dh, lane, hi);
    }
#pragma unroll
    for (int dt = 0; dt < 4; ++dt)
#pragma unroll
        for (int r = 0; r < 16; ++r) SLOC[((size_t)(s * 4 + h) * 256 + 128 * dh + 32 * dt + crow(r, hi)) * 512 + e0 + r32] = St[dt][r];
    if (sl == 0 && tid < 256) ((float*)(ws + WS_G + MiB))[(s * 4 + h) * 256 + tid] = gprod;
    LBAR();
}

__device__ __forceinline__ void gla_s2_phase(const Params& p, int gtid) {
    unsigned char* ws = p.ws;
    const float* GSEG = (const float*)(ws + WS_G + MiB); const f32x4* SLOC = (const f32x4*)(ws + WS_SLOC); f32x4* SINIT = (f32x4*)(ws + WS_SINIT);
    const int h = gtid >> 15, d = (gtid >> 7) & 255;
    float gs[15]; f32x4 sl[15];
#pragma unroll
    for (int s = 0; s < 15; ++s) { gs[s] = GSEG[(s * 4 + h) * 256 + d]; sl[s] = SLOC[(size_t)s * 131072 + gtid]; }
    f32x4 cur = (f32x4){0.f, 0.f, 0.f, 0.f};
#pragma unroll
    for (int s = 0; s < 16; ++s) {
        SINIT[(size_t)s * 131072 + gtid] = cur;
        if (s < 15) cur = cur * gs[s] + sl[s];
    }
}

__device__ __forceinline__ void gla_s3_unit(const Params& p, int s, int h, int sl, LAS unsigned char* lds, int tid, int wave, int lane) {
    unsigned char* ws = p.ws;
    const bf16* QT = (const bf16*)(ws + WS_QT); const bf16* KTT = (const bf16*)(ws + WS_KTT); const bf16* VT = (const bf16*)(ws + WS_VT); const bf16* AG = (const bf16*)(ws + WS_AG);
    const float* G = (const float*)(ws + WS_G); const float* SINIT = (const float*)(ws + WS_SINIT); bf16* OG = (bf16*)(ws + WS_OG);
    const int dh = wave >> 2, eb = wave & 3, r32 = lane & 31, hi = lane >> 5, e0 = 128 * sl + 32 * eb;
    LAS bf16* KBl = (LAS bf16*)(lds + 65536); LAS float* X = (LAS float*)(lds + 98304); LAS float* GBl = (LAS float*)(lds + 131072);
    v4u pq[4], pk[4]; float pg = 0.f;
    { const int ch = (s * 8) * 4 + h; const v4u* qp = (const v4u*)(QT + (size_t)ch * 16384) + tid; const v4u* kp = (const v4u*)(KTT + (size_t)ch * 16384) + tid;
#pragma unroll
      for (int i = 0; i < 4; ++i) { pq[i] = qp[512 * i]; pk[i] = kp[512 * i]; }
      if (tid < 256) pg = G[(size_t)ch * 256 + tid]; }
    f32x16 St[4];
#pragma unroll
    for (int dt = 0; dt < 4; ++dt)
#pragma unroll
        for (int r = 0; r < 16; ++r) St[dt][r] = SINIT[((size_t)(s * 4 + h) * 256 + 128 * dh + 32 * dt + crow(r, hi)) * 512 + e0 + r32];
#pragma unroll
    for (int i = 0; i < 4; ++i) *((LAS v4u*)lds + tid + 512 * i) = pq[i];
    bf16x8 afr[4], vfr[4];
    { const int ch0 = (s * 8) * 4 + h;
#pragma unroll
      for (int ks = 0; ks < 4; ++ks) {
        afr[ks] = *(const bf16x8*)(AG + ((size_t)ch0 * 64 + 32 * dh + r32) * 64 + 16 * ks + 8 * hi);
        vfr[ks] = *(const bf16x8*)(VT + (size_t)ch0 * 32768 + (((e0 >> 5) * 4 + ks) * 64 + lane) * 8); } }
    LBAR();
#pragma unroll 1
    for (int cc = 0; cc < 8; ++cc) {
        const int c = s * 8 + cc, ch = c * 4 + h, cur = cc & 1;
        const LAS bf16* QBl = (const LAS bf16*)(lds + cur * 32768);
        if (cc < 7) { const v4u* qp = (const v4u*)(QT + (size_t)(ch + 4) * 16384) + tid;
#pragma unroll
            for (int i = 0; i < 4; ++i) pq[i] = qp[512 * i]; }
        f32x16 op0, op1;
#pragma unroll
        for (int r = 0; r < 16; ++r) { op0[r] = 0.f; op1[r] = 0.f; }
#pragma unroll
        for (int dt = 0; dt < 4; ++dt)
#pragma unroll
            for (int ss = 0; ss < 2; ++ss) {
                const bf16x8 sb = pack8(St[dt][8 * ss + 0], St[dt][8 * ss + 1], St[dt][8 * ss + 2], St[dt][8 * ss + 3], St[dt][8 * ss + 4], St[dt][8 * ss + 5], St[dt][8 * ss + 6], St[dt][8 * ss + 7]);
                const LAS bf16* qp = QBl + ((8 * dh + 2 * dt + ss) * 64 + lane) * 8;
                const bf16x8 q0 = *(const LAS bf16x8*)qp; const bf16x8 q1 = *(const LAS bf16x8*)(qp + 16 * 512);
                op0 = MFMA32(q0, sb, op0); op1 = MFMA32(q1, sb, op1);
            }
        f32x16 keep, send;
#pragma unroll
        for (int r = 0; r < 16; ++r) { keep[r] = dh ? op1[r] : op0[r]; send[r] = dh ? op0[r] : op1[r]; }
        { LAS float* xd = X + ((1 - dh) * 4 + eb) * 1024 + lane;
#pragma unroll
          for (int r = 0; r < 16; ++r) xd[r * 64] = send[r]; }
#pragma unroll
        for (int i = 0; i < 4; ++i) *((LAS v4u*)KBl + tid + 512 * i) = pk[i];
        if (tid < 256) GBl[tid] = pg;
        LBAR();
        { const LAS float* xs = X + wave * 1024 + lane;
#pragma unroll
          for (int r = 0; r < 16; ++r) keep[r] += xs[r * 64]; }
        if (cc < 7) { const v4u* kp = (const v4u*)(KTT + (size_t)(ch + 4) * 16384) + tid;
#pragma unroll
            for (int i = 0; i < 4; ++i) pk[i] = kp[512 * i];
            if (tid < 256) pg = G[(size_t)(ch + 4) * 256 + tid]; }
#pragma unroll
        for (int ks = 0; ks < 4; ++ks) keep = MFMA32(afr[ks], vfr[ks], keep);
        if (cc < 7) {
#pragma unroll
            for (int ks = 0; ks < 4; ++ks) afr[ks] = *(const bf16x8*)(AG + ((size_t)(ch + 4) * 64 + 32 * dh + r32) * 64 + 16 * ks + 8 * hi); }
#pragma unroll
        for (int r = 0; r < 16; ++r) OG[((size_t)c * 64 + 32 * dh + crow(r, hi)) * DM + h * 512 + e0 + r32] = (bf16)f2bf(keep[r]);
        gla_state_update_lds(St, GBl, KBl, vfr, dh, lane, hi);
        if (cc < 7) {
#pragma unroll
            for (int ks = 0; ks < 4; ++ks) vfr[ks] = *(const bf16x8*)(VT + (size_t)(ch + 4) * 32768 + (((e0 >> 5) * 4 + ks) * 64 + lane) * 8); }
        if (cc < 7) {
#pragma unroll
            for (int i = 0; i < 4; ++i) *((LAS v4u*)(lds + (cur ^ 1) * 32768) + tid + 512 * i) = pq[i]; }
        LBAR();
    }
}

__device__ __forceinline__ void gla_post_phase(const Params& p, int li, int gw, int NGW, int lane) {
    unsigned char* ws = p.ws;
    const bf16* OG = (const bf16*)(ws + WS_OG); const bf16* PROJ = (const bf16*)(ws + WS_PROJ); bf16* Y = (bf16*)(ws + WS_Y);
    const float* go = p.in[8] + li * 512;
    const f32x4 ga = *(const f32x4*)(go + 8 * lane), gb = *(const f32x4*)(go + 8 * lane + 4);
    for (int row = gw; row < SEQ; row += NGW) {
#pragma unroll
        for (int hh = 0; hh < 4; ++hh) {
            const v4u ow = *(const v4u*)(OG + (size_t)row * DM + hh * 512 + 8 * lane);
            const f32x4 a = (f32x4){bflo(ow.x), bfhi(ow.x), bflo(ow.y), bfhi(ow.y)}, b = (f32x4){bflo(ow.z), bfhi(ow.z), bflo(ow.w), bfhi(ow.w)};
            float ss = (a.x * a.x + a.y * a.y) + (a.z * a.z + a.w * a.w) + (b.x * b.x + b.y * b.y) + (b.z * b.z + b.w * b.w);
            const float rstd = 1.0f / sqrtf(wave_sum(ss) * (1.0f / 512.f) + EPS);
            const v4u rr = *(const v4u*)(PROJ + (size_t)row * NPROJ + 4096 + hh * 512 + 8 * lane);
            float rv[8] = {bflo(rr.x), bfhi(rr.x), bflo(rr.y), bfhi(rr.y), bflo(rr.z), bfhi(rr.z), bflo(rr.w), bfhi(rr.w)};
            float yv[8] = {a.x * ga.x, a.y * ga.y, a.z * ga.z, a.w * ga.w, b.x * gb.x, b.y * gb.y, b.z * gb.z, b.w * gb.w};
#pragma unroll
            for (int k = 0; k < 8; ++k) yv[k] = yv[k] * rstd * (rv[k] * __builtin_amdgcn_rcpf(1.0f + __expf(-rv[k])));
            v4u o; o.x = pk2(yv[0], yv[1]); o.y = pk2(yv[2], yv[3]); o.z = pk2(yv[4], yv[5]); o.w = pk2(yv[6], yv[7]);
            *(v4u*)(Y + (size_t)row * DM + hh * 512 + 8 * lane) = o;
        }
    }
}

__device__ __forceinline__ void attn_unit(const Params& p, int lj, int nb, int kh, LAS unsigned char* lds, int tid, int wave, int lane) {
    unsigned char* ws = p.ws;
    const bf16* Q = (const bf16*)(ws + WS_QB); const bf16* KV = (const bf16*)(ws + WS_KVB); bf16* O = (bf16*)(ws + WS_OB);
    const float* gq = p.in[15] + lj * 64; const float* gk = p.in[13]; const float* sinks = p.in[16] + lj * 32;
    LAS bf16* Kl = (LAS bf16*)lds; LAS bf16* VTl = (LAS bf16*)(lds + 36864);
    {
        const int key = tid >> 1, half = tid & 1; const int grow = 128 * (nb - 1) + key;
        v4u kr[4], vr[4];
        if (grow >= 0) {
            const v4u* kp = (const v4u*)(KV + (size_t)grow * 512 + kh * 64 + 32 * half); const v4u* vp = (const v4u*)(KV + (size_t)grow * 512 + 256 + kh * 64 + 32 * half);
#pragma unroll
            for (int i = 0; i < 4; ++i) { kr[i] = kp[i]; vr[i] = vp[i]; }
        } else {
#pragma unroll
            for (int i = 0; i < 4; ++i) { kr[i] = (v4u){0u, 0u, 0u, 0u}; vr[i] = (v4u){0u, 0u, 0u, 0u}; }
        }
        float kf[32]; float ss = 0.f;
#pragma unroll
        for (int i = 0; i < 4; ++i)
#pragma unroll
            for (int j = 0; j < 4; ++j) { const unsigned w = kr[i][j]; kf[8 * i + 2 * j] = bflo(w); kf[8 * i + 2 * j + 1] = bfhi(w); }
#pragma unroll
        for (int i = 0; i < 32; ++i) ss += kf[i] * kf[i];
        ss += __shfl_xor(ss, 1);
        const float sc = 1.0f / sqrtf(ss * (1.0f / 64.f) + EPS);
#pragma unroll
        for (int i = 0; i < 32; ++i) kf[i] = kf[i] * sc * gk[32 * half + i];
#pragma unroll
        for (int i = 0; i < 4; ++i) { v4u o; o.x = pk2(kf[8 * i], kf[8 * i + 1]); o.y = pk2(kf[8 * i + 2], kf[8 * i + 3]); o.z = pk2(kf[8 * i + 4], kf[8 * i + 5]); o.w = pk2(kf[8 * i + 6], kf[8 * i + 7]);
            *(LAS v4u*)(Kl + key * 72 + 32 * half + 8 * i) = o; }
        const int pos = (key & ~15) | swap23(key & 15);
#pragma unroll
        for (int i = 0; i < 4; ++i)
#pragma unroll
            for (int j = 0; j < 4; ++j) { const unsigned w = vr[i][j];
                VTl[(32 * half + 8 * i + 2 * j) * 264 + pos] = (bf16)(w & 0xffffu); VTl[(32 * half + 8 * i + 2 * j + 1) * 264 + pos] = (bf16)(w >> 16); }
    }
    __syncthreads();
    const int r32 = lane & 31, hi = lane >> 5, qh = kh * 8 + wave;
    const float sink2 = sinks[qh] * LOG2E;
    float gqv[4][8];
#pragma unroll
    for (int ks = 0; ks < 4; ++ks)
#pragma unroll
        for (int j = 0; j < 8; ++j) gqv[ks][j] = gq[16 * ks + 8 * hi + j];
#pragma unroll 1
    for (int qb = 0; qb < 4; ++qb) {
        const size_t row = (size_t)128 * nb + 32 * qb + r32;
        const bf16* qp = Q + row * DM + qh * 64 + 8 * hi;
        float qf[4][8]; float ss = 0.f;
#pragma unroll
        for (int ks = 0; ks < 4; ++ks) { const v4u w = *(const v4u*)(qp + 16 * ks);
#pragma unroll
            for (int j = 0; j < 4; ++j) { qf[ks][2 * j] = bflo(w[j]); qf[ks][2 * j + 1] = bfhi(w[j]); } }
#pragma unroll
        for (int ks = 0; ks < 4; ++ks)
#pragma unroll
            for (int j = 0; j < 8; ++j) ss += qf[ks][j] * qf[ks][j];
        ss += __shfl_xor(ss, 32);
        const float rs = (1.0f / sqrtf(ss * (1.0f / 64.f) + EPS)) * 0.125f * LOG2E;
        bf16x8 qfr[4];
#pragma unroll
        for (int ks = 0; ks < 4; ++ks) qfr[ks] = pack8(qf[ks][0] * rs * gqv[ks][0], qf[ks][1] * rs * gqv[ks][1], qf[ks][2] * rs * gqv[ks][2], qf[ks][3] * rs * gqv[ks][3],
                                                        qf[ks][4] * rs * gqv[ks][4], qf[ks][5] * rs * gqv[ks][5], qf[ks][6] * rs * gqv[ks][6], qf[ks][7] * rs * gqv[ks][7]);
        f32x16 sc[5];
#pragma unroll
        for (int t = 0; t < 5; ++t) {
#pragma unroll
            for (int r = 0; r < 16; ++r) sc[t][r] = 0.f;
#pragma unroll
            for (int ks = 0; ks < 4; ++ks) { const bf16x8 kfr = *(const LAS bf16x8*)(Kl + (32 * (qb + t) + r32) * 72 + 16 * ks + 8 * hi); sc[t] = MFMA32(kfr, qfr[ks], sc[t]); }
        }
        const int qi = 32 * qb + r32; float m = sink2;
#pragma unroll
        for (int t = 0; t < 5; ++t)
#pragma unroll
            for (int r = 0; r < 16; ++r) { const int kj = 32 * (qb + t) + crow(r, hi); const int rel = qi + 128 - kj;
                const bool valid = (rel >= 0) && (rel < 128) && (nb > 0 || kj >= 128);
                sc[t][r] = valid ? sc[t][r] : -INFINITY; m = fmaxf(m, sc[t][r]); }
        m = fmaxf(m, __shfl_xor(m, 32));
        float l = 0.f;
#pragma unroll
        for (int t = 0; t < 5; ++t)
#pragma unroll
            for (int r = 0; r < 16; ++r) { const float pe = __builtin_amdgcn_exp2f(sc[t][r] - m); sc[t][r] = pe; l += pe; }
        l += __shfl_xor(l, 32); l += __builtin_amdgcn_exp2f(sink2 - m);
        f32x16 ot0, ot1;
#pragma unroll
        for (int r = 0; r < 16; ++r) { ot0[r] = 0.f; ot1[r] = 0.f; }
#pragma unroll
        for (int t = 0; t < 5; ++t)
#pragma unroll
            for (int s = 0; s < 2; ++s) {
                const bf16x8 pf = pack8(sc[t][8 * s + 0], sc[t][8 * s + 1], sc[t][8 * s + 2], sc[t][8 * s + 3], sc[t][8 * s + 4], sc[t][8 * s + 5], sc[t][8 * s + 6], sc[t][8 * s + 7]);
                const LAS bf16* vp = VTl + r32 * 264 + 32 * (qb + t) + 16 * s + 8 * hi;
                const bf16x8 v0 = *(const LAS bf16x8*)vp; const bf16x8 v1 = *(const LAS bf16x8*)(vp + 32 * 264);
                ot0 = MFMA32(v0, pf, ot0); ot1 = MFMA32(v1, pf, ot1);
            }
        const float inv = 1.0f / l;
        bf16* orow = O + row * DM + qh * 64 + 4 * hi;
#pragma unroll
        for (int rg = 0; rg < 4; ++rg) {
            v2u w0; w0.x = pk2(ot0[4 * rg] * inv, ot0[4 * rg + 1] * inv); w0.y = pk2(ot0[4 * rg + 2] * inv, ot0[4 * rg + 3] * inv); *(v2u*)(orow + 8 * rg) = w0;
            v2u w1; w1.x = pk2(ot1[4 * rg] * inv, ot1[4 * rg + 1] * inv); w1.y = pk2(ot1[4 * rg + 2] * inv, ot1[4 * rg + 3] * inv); *(v2u*)(orow + 32 + 8 * rg) = w1;
        }
    }
    __syncthreads();
}

__global__ void __launch_bounds__(NTHR, 2) yoco_fwd(Params p) {
    __shared__ __attribute__((aligned(16))) unsigned char lds_raw[LDS_BYTES];
    LAS unsigned char* lds = (LAS unsigned char*)lds_raw;
    cg::grid_group grid = cg::this_grid();
#ifndef REP_GLA
#define REP_GLA 1
#endif
#ifndef REP_CONV
#define REP_CONV 1
#endif
#ifndef EXTRA_SYNC
#define EXTRA_SYNC 0
#endif
#ifndef REP_NORM
#define REP_NORM 1
#endif
#ifndef CUT
#define CUT 1000
#endif
#define PHC() do { if (phc++ >= CUT) return; } while (0)
#define PWS() Params q = p; int bxq = blockIdx.x; asm volatile("" : "+s"(q.ws), "+s"(q.out), "+s"(bxq))
#define TIDS() int tid = threadIdx.x; asm volatile("" : "+v"(tid)); const int lane = tid & 63, wave = __builtin_amdgcn_readfirstlane(tid >> 6); const int gw = vcu * NWAVES + wave
    const int G = gridDim.x, bx = blockIdx.x; int phc = 0;
    volatile LAS unsigned* bst = (volatile LAS unsigned*)(lds + LDS_BYTES - 64);
    if (threadIdx.x < 2) bst[threadIdx.x] = 0u;
    __syncthreads();
    const XcdBarrier xbar = xcd_barrier_post((unsigned*)p.ws + 1024, bst);
#define GSYNC() xcd_barrier(xbar)
    const int vcu = (G % 8 == 0) ? (bx % 8) * (G / 8) + bx / 8 : bx;
    const int NGW = G * NWAVES;
    { PHC(); PWS(); TIDS(); convert_phase(q, lds, gw, NGW, wave, lane); }
    __syncthreads();
    { PHC(); PWS(); TIDS(); norm_phase<true, false, false>(q.in[0], nullptr, ((bf16*)(q.ws + WS_UN)), q.in[1], ((bf16*)(q.ws + WS_XN)), q.in[5], ((float*)(q.ws + WS_GLR)), nullptr, nullptr, lds, gw, NGW, tid, lane); }
    GSYNC();
    if (p.ws == nullptr) grid.sync();
#pragma unroll 1
    for (int layer = 0; layer < 4; ++layer) {

        if (layer < 2) {
            if (layer == 1) {
                { PHC(); PWS(); TIDS(); norm_phase<true, false, true>(nullptr, ((const bf16*)(q.ws + WS_UN)), nullptr, q.in[1] + layer * DM, ((bf16*)(q.ws + WS_XN)), q.in[5] + (size_t)layer * DM * GIN, ((float*)(q.ws + WS_GLR)), nullptr, nullptr, lds, gw, NGW, tid, lane); }
                GSYNC();
            }
            { PHC(); PWS(); pg8::Gemm g{((bf16*)(q.ws + WS_XN)), (const bf16*)(q.ws + WS_WINT) + (size_t)layer * NPROJ * DM, SEQ, NPROJ, DM}; pg8::StaticOrder S; S.init(SEQ, NPROJ, G, bxq);
              pg8::EpiBf16<0, false> E{(bf16*)(q.ws + WS_PROJ), NPROJ, nullptr};
              pg8::gemm_phase<pg8::EpiBf16<0, false>, pg8::StaticOrder, true, true>(lds, g, S, E); }
            GSYNC();
            { PHC(); PWS(); TIDS(); (void)gw; for (int u = bxq; u < 512; u += G) gla_prep_unit(q, layer, u >> 2, u & 3, lds, tid, wave, lane); }
            GSYNC();
            { PHC(); PWS(); TIDS(); (void)gw; for (int u = vcu; u < 240; u += G) gla_s1_unit(q, u >> 4, (u >> 2) & 3, u & 3, lds, tid, wave, lane); }
            GSYNC();
            { PHC(); PWS(); TIDS(); (void)gw; (void)lane; for (int gt = bxq * NTHR + tid; gt < 131072; gt += G * NTHR) gla_s2_phase(q, gt); }
            GSYNC();
            { PHC(); PWS(); TIDS(); (void)gw; for (int u = vcu; u < 256; u += G) gla_s3_unit(q, u >> 4, (u >> 2) & 3, u & 3, lds, tid, wave, lane); }
            GSYNC();
            { PHC(); PWS(); TIDS(); gla_post_phase(q, layer, gw, NGW, lane); }
            GSYNC();
            { PHC(); PWS(); pg8::Gemm g{(const bf16*)(q.ws + WS_Y), (const bf16*)(q.ws + WS_WOAT) + (size_t)layer * DM * DM, SEQ, DM, DM}; pg8::StaticOrder S; S.init(SEQ, DM, G, bxq);
              pg8::EpiRes<false> E{((bf16*)(q.ws + WS_UN)), nullptr, DM, ((float*)(q.ws + 613 * MiB)), nullptr};
              pg8::gemm_phase<pg8::EpiRes<false>, pg8::StaticOrder, true, true>(lds, g, S, E); }
            GSYNC();
        } else {
            const int lj = layer - 2;
            { PHC(); PWS(); pg8::Gemm g{((bf16*)(q.ws + WS_UN)), (const bf16*)(q.ws + WS_WQT) + (size_t)lj * DM * DM, SEQ, DM, DM}; pg8::StaticOrder S; S.init(SEQ, DM, G, bxq);
              pg8::EpiBf16<0, false> E{(bf16*)(q.ws + WS_QB), DM, nullptr};
              pg8::gemm_phase<pg8::EpiBf16<0, false>, pg8::StaticOrder, true, true>(lds, g, S, E); }
            if (layer == 2) {
              PHC(); PWS(); pg8::Gemm g{((bf16*)(q.ws + WS_UN)), (const bf16*)(q.ws + WS_WKVT), SEQ, 512, DM}; pg8::StaticOrder S; S.init(SEQ, 512, G, bxq);
              pg8::EpiBf16<0, true> E{(bf16*)(q.ws + WS_KVB), 512, ((float*)(q.ws + 812 * MiB))};
              pg8::gemm_phase<pg8::EpiBf16<0, true>, pg8::StaticOrder, true, true>(lds, g, S, E); }
            GSYNC();
            { PHC(); PWS(); TIDS(); (void)gw; for (int u = vcu; u < 256; u += G) attn_unit(q, lj, u >> 2, u & 3, lds, tid, wave, lane); }
            GSYNC();
            { PHC(); PWS(); pg8::Gemm g{(const bf16*)(q.ws + WS_OB), (const bf16*)(q.ws + WS_WOBT) + (size_t)lj * DM * DM, SEQ, DM, DM}; pg8::StaticOrder S; S.init(SEQ, DM, G, bxq);
              pg8::EpiRes<false> E{((bf16*)(q.ws + WS_UN)), nullptr, DM, ((float*)(q.ws + 613 * MiB)), nullptr};
              pg8::gemm_phase<pg8::EpiRes<false>, pg8::StaticOrder, true, true>(lds, g, S, E); }
            GSYNC();
        }
        { PHC(); PWS(); pg8::Gemm g{((bf16*)(q.ws + WS_UN)), (const bf16*)(q.ws + WS_W1T) + (size_t)layer * FF * DM, SEQ, FF, DM}; pg8::StaticOrder S; S.init(SEQ, FF, G, bxq);
          pg8::EpiBf16<2, false> E{((bf16*)(q.ws + WS_HB)), FF, nullptr};
          pg8::gemm_phase<pg8::EpiBf16<2, false>, pg8::StaticOrder, true, true>(lds, g, S, E); }
        GSYNC();
        if (layer < 3) { PHC(); PWS(); pg8::Gemm g{((bf16*)(q.ws + WS_HB)), (const bf16*)(q.ws + WS_W2T) + (size_t)layer * DM * FF, SEQ, DM, FF}; pg8::StaticOrder S; S.init(SEQ, DM, G, bxq);
          pg8::EpiRes<false> E{((bf16*)(q.ws + WS_UN)), nullptr, DM, ((float*)(q.ws + 812 * MiB)), ((const float*)(q.ws + 613 * MiB))};
          pg8::gemm_phase<pg8::EpiRes<false>, pg8::StaticOrder, true, true>(lds, g, S, E); }
        else { PHC(); PWS(); pg8::Gemm g{((bf16*)(q.ws + WS_HB)), (const bf16*)(q.ws + WS_W2T) + (size_t)layer * DM * FF, SEQ, DM, FF}; pg8::StaticOrder S; S.init(SEQ, DM, G, bxq);
          pg8::EpiRes<true> E{((bf16*)(q.ws + WS_UN)), q.out, DM, nullptr, ((const float*)(q.ws + 613 * MiB))};
          pg8::gemm_phase<pg8::EpiRes<true>, pg8::StaticOrder, true, true>(lds, g, S, E); }
        GSYNC();
    }
}

extern "C" void kernel_launch(void* const* d_in, const int* in_sizes, int n_in, void* d_out, int out_size, void* d_ws, size_t ws_size, hipStream_t stream) {
    static int grid = 0;
    if (grid == 0) {
        if (n_in != 18 || out_size != SEQ * DM || ws_size < WS_END) { fprintf(stderr, "kernel_launch: unexpected shapes (n_in %d out %d ws %zu)\n", n_in, out_size, ws_size); grid = -1; return; }
        int dev = 0, cus = 0, per_cu = 0;
        hipGetDevice(&dev); hipDeviceGetAttribute(&cus, hipDeviceAttributeMultiprocessorCount, dev);
        hipOccupancyMaxActiveBlocksPerMultiprocessor(&per_cu, (const void*)yoco_fwd, NTHR, 0);
        (void)hipGetLastError();
        if (per_cu < 1) per_cu = 1;
        grid = cus;
        if (grid > 256) grid = 256;
    }
    if (grid < 0) return;
    if (hipMemsetAsync(d_ws, 0, 65536, stream) != hipSuccess) { fprintf(stderr, "kernel_launch: memset failed\n"); return; }
    Params p{};
    for (int i = 0; i < 18; ++i) p.in[i] = (const float*)d_in[i];
    p.out = (float*)d_out; p.ws = (unsigned char*)d_ws;
    void* args[] = {&p};
    hipError_t e = hipLaunchCooperativeKernel((const void*)yoco_fwd, dim3(grid), dim3(NTHR), args, 0, stream);
    if (e != hipSuccess) fprintf(stderr, "cooperative launch failed: %s (grid %d)\n", hipGetErrorString(e), grid);
}
```

```cpp
#include <hip/hip_runtime.h>
#include <hip/hip_cooperative_groups.h>
#include <cstdio>
#include <cstdint>
namespace cg = cooperative_groups;

namespace pg8 {
#define PG8_LAS __attribute__((address_space(3)))
typedef unsigned short bf16_t;
typedef short bf16x8 __attribute__((ext_vector_type(8)));
typedef float f32x4 __attribute__((ext_vector_type(4)));
typedef unsigned u32x4 __attribute__((ext_vector_type(4)));
constexpr int BM = 256, BK = 64, HALF = 128, HTB = HALF * BK * 2, STAGE_BYTES = 8 * HTB, NXCD = 8, WGM = 8;

__host__ __device__ __forceinline__ int lds_byte(int r, int c) { const int st = (r >> 4) * 2 + (c >> 5), rr = r & 15, cc = c & 31, ob = rr * 64 + cc * 2; return st * 1024 + (ob ^ (((ob >> 9) & 1) << 5)); }
__host__ __device__ __forceinline__ void stage_rc(int b, int& R, int& C) { const int st = b / 1024, sb = b % 1024, swz = sb ^ (((sb >> 9) & 1) << 5); R = (st >> 1) * 16 + swz / 64; C = (st & 1) * 32 + (swz % 64) / 2; }
__host__ __device__ __forceinline__ int perm32(int rho) { const int n = rho >> 4, i = rho & 15; return 8 * (i >> 2) + 4 * n + (i & 3); }

struct Unit { int pm, pn; };
struct Gemm { const bf16_t* A; const bf16_t* Bt; int M, N, K; };

struct StaticOrder {
    int nM, nN, nwg, G, c;
    __host__ __device__ void init(int M, int N, int G_, int c_) { nM = M / BM; nN = N / BM; nwg = nM * nN; G = G_; c = c_; }
    __host__ __device__ bool next(int i, Unit& u) const {
        const long L = (long)i * G + c; if (L >= nwg) return false;
        int wgid = (int)L; { const int q = nwg / NXCD, r = nwg % NXCD, xcd = wgid % NXCD, off = wgid / NXCD; wgid = (xcd < r ? xcd * (q + 1) : r * (q + 1) + (xcd - r) * q) + off; }
        const int nig = WGM * nN, gid = wgid / nig, fm = gid * WGM, gsz = (nM - fm) < WGM ? (nM - fm) : WGM;
        u.pm = fm + ((wgid % nig) % gsz); u.pn = (wgid % nig) / gsz; return true;
    }
    __device__ __forceinline__ void a_ready(const Unit&) const {}
    __device__ __forceinline__ void done(const Unit&) const {}
};

__device__ __forceinline__ unsigned cvt_pk_bf16(float lo, float hi) { unsigned r; asm volatile("v_cvt_pk_bf16_f32 %0, %1, %2" : "=v"(r) : "v"(lo), "v"(hi)); return r; }

template <int ACT, bool RS> struct EpiBf16 {
    static constexpr bool PERM = true, AFTER_DRAIN = false;
    bf16_t* O; int ldc; const float* ssq;
    __device__ __forceinline__ void operator()(const f32x4 (&acc)[2][2][4][2], const Unit& u, int wr, int wc, int fr, int fq) const {
        const int row0 = u.pm * BM + wr * 64 + fr; const int col0 = u.pn * BM + wc * 32 + 8 * fq;
#pragma unroll
        for (int ai = 0; ai < 2; ++ai)
#pragma unroll
            for (int m = 0; m < 4; ++m) { const int row = row0 + ai * HALF + m * 16; bf16_t* rowp = O + (size_t)row * ldc + col0;
                float rs = 1.f;
                if (RS) { const f32x4 a = *(const f32x4*)(ssq + (size_t)row * 32 + fq * 8), b = *(const f32x4*)(ssq + (size_t)row * 32 + fq * 8 + 4);
                    float s = ((a.x + a.y) + (a.z + a.w)) + ((b.x + b.y) + (b.z + b.w)); s += __shfl_xor(s, 16); s += __shfl_xor(s, 32);
                    rs = 1.0f / sqrtf(s * (1.0f / 2048.f) + 1e-6f); }
#pragma unroll
                for (int bj = 0; bj < 2; ++bj) { f32x4 v0 = acc[ai][bj][m][0], v1 = acc[ai][bj][m][1];
                    if (RS) { v0 = v0 * rs; v1 = v1 * rs; }
                    if (ACT == 2) {
#pragma unroll
                        for (int e = 0; e < 4; ++e) { float a = fmaxf(v0[e], 0.f), b = fmaxf(v1[e], 0.f); v0[e] = a * a; v1[e] = b * b; } }
                    u32x4 w; w.x = cvt_pk_bf16(v0[0], v0[1]); w.y = cvt_pk_bf16(v0[2], v0[3]); w.z = cvt_pk_bf16(v1[0], v1[1]); w.w = cvt_pk_bf16(v1[2], v1[3]);
                    *(u32x4*)(rowp + bj * HALF) = w; } }
    }
};
template <bool OUT_F32> struct EpiRes {
    static constexpr bool PERM = true, AFTER_DRAIN = false;
    bf16_t* h; float* outf; int ldc; float* ssq; const float* ssq_in;
    __device__ __forceinline__ void operator()(const f32x4 (&acc)[2][2][4][2], const Unit& u, int wr, int wc, int fr, int fq) const {
        const int col0 = u.pn * BM + wc * 32 + 8 * fq;
#pragma unroll
        for (int ai = 0; ai < 2; ++ai) {
            float rs2[4];
#pragma unroll
            for (int m = 0; m < 4; ++m) { rs2[m] = 1.f;
                if (ssq_in) { const int row = u.pm * BM + ai * HALF + wr * 64 + m * 16 + fr;
                    const f32x4 a = *(const f32x4*)(ssq_in + (size_t)row * 32 + fq * 8), b = *(const f32x4*)(ssq_in + (size_t)row * 32 + fq * 8 + 4);
                    float s = ((a.x + a.y) + (a.z + a.w)) + ((b.x + b.y) + (b.z + b.w)); s += __shfl_xor(s, 16); s += __shfl_xor(s, 32);
                    rs2[m] = 1.0f / (s * (1.0f / 2048.f) + 1e-6f); } }
            asm volatile("" : "+v"(rs2[0]), "+v"(rs2[1]), "+v"(rs2[2]), "+v"(rs2[3]) :: "memory");
            u32x4 pre[4][2];
#pragma unroll
            for (int m = 0; m < 4; ++m) { const size_t off = (size_t)(u.pm * BM + ai * HALF + wr * 64 + m * 16 + fr) * ldc + col0;
#pragma unroll
                for (int bj = 0; bj < 2; ++bj) pre[m][bj] = *(const u32x4*)(h + off + bj * HALF); }
#pragma unroll
            for (int m = 0; m < 4; ++m) { const int row = u.pm * BM + ai * HALF + wr * 64 + m * 16 + fr; const size_t off = (size_t)row * ldc + col0; float s = 0.f;
#pragma unroll
                for (int bj = 0; bj < 2; ++bj) { const u32x4 pw = pre[m][bj];
                    const f32x4 b0 = (f32x4){__builtin_bit_cast(float, pw.x << 16), __builtin_bit_cast(float, pw.x & 0xffff0000u), __builtin_bit_cast(float, pw.y << 16), __builtin_bit_cast(float, pw.y & 0xffff0000u)};
                    const f32x4 b1 = (f32x4){__builtin_bit_cast(float, pw.z << 16), __builtin_bit_cast(float, pw.z & 0xffff0000u), __builtin_bit_cast(float, pw.w << 16), __builtin_bit_cast(float, pw.w & 0xffff0000u)};
                    const f32x4 o0 = b0 + acc[ai][bj][m][0] * rs2[m], o1 = b1 + acc[ai][bj][m][1] * rs2[m];
                    if (OUT_F32) { *(f32x4*)(outf + off + bj * HALF) = o0; *(f32x4*)(outf + off + bj * HALF + 4) = o1; }
                    else { s += ((o0.x * o0.x + o0.y * o0.y) + (o0.z * o0.z + o0.w * o0.w)) + ((o1.x * o1.x + o1.y * o1.y) + (o1.z * o1.z + o1.w * o1.w));
                        u32x4 w; w.x = cvt_pk_bf16(o0.x, o0.y); w.y = cvt_pk_bf16(o0.z, o0.w); w.z = cvt_pk_bf16(o1.x, o1.y); w.w = cvt_pk_bf16(o1.z, o1.w); *(u32x4*)(h + off + bj * HALF) = w; } }
                if (!OUT_F32) { s += __shfl_xor(s, 16); s += __shfl_xor(s, 32);
                    if (fq == 0) ssq[(size_t)row * 32 + u.pn * 4 + wc] = s; } }
            asm volatile("" ::: "memory");
        }
    }
};

template <class Epi, class Sched, bool ALIGN_EPI = false, bool SP2 = false>
__device__ __forceinline__ void gemm_phase(PG8_LAS unsigned char* lds, const Gemm g, const Sched& S, const Epi& E) {
    int tid_l = threadIdx.x; asm volatile("" : "+v"(tid_l));
    const int tid = tid_l, wid = __builtin_amdgcn_readfirstlane(tid >> 6), lane = tid & 63, wr = wid >> 2, wc = wid & 3, fr = lane & 15, fq = lane >> 4;
    const int K = g.K, nt = K / BK;
    unsigned voffA[2], voffB[2];
#pragma unroll
    for (int i = 0; i < 2; ++i) { int R, C; stage_rc(tid * 16 + i * 8192, R, C); const int Rb = Epi::PERM ? ((R & ~31) + perm32(R & 31)) : R;
        voffA[i] = (unsigned)(R * K + C) * 2u; voffB[i] = (unsigned)(Rb * K + C) * 2u; }
    const size_t kstep = (size_t)(BK * 2);
    const size_t hstep = (size_t)HALF * K * 2;
    const size_t tstep = 2 * hstep;
    const unsigned ldsw = (unsigned)wid * 1024u;
    const int aoff = lds_byte(wr * 64 + fr, fq * 8), boff = lds_byte(wc * 32 + fr, fq * 8);
#define PG8_SA(b, h) (((b) * 2 + (h)) * HTB)
#define PG8_SB(b, h) ((4 + (b) * 2 + (h)) * HTB)
#define PG8_STAGE(bufoff, gbase, voff) do { _Pragma("unroll") for (int _i = 0; _i < 2; ++_i) \
        __builtin_amdgcn_global_load_lds((const unsigned*)((const char*)(gbase) + (voff)[_i]), (PG8_LAS unsigned*)(lds + (bufoff) + ldsw + _i * 8192), 16, 0, 0); } while (0)
#define PG8_LDA(dst, b, h) do { _Pragma("unroll") for (int m = 0; m < 4; ++m) _Pragma("unroll") for (int k = 0; k < 2; ++k) dst[m][k] = *(const PG8_LAS bf16x8*)(lds + PG8_SA(b, h) + aoff + m * 2048 + k * 1024); } while (0)
#define PG8_LDB(dst, b, h) do { _Pragma("unroll") for (int n = 0; n < 2; ++n) _Pragma("unroll") for (int k = 0; k < 2; ++k) dst[n][k] = *(const PG8_LAS bf16x8*)(lds + PG8_SB(b, h) + boff + n * 2048 + k * 1024); } while (0)
#define PG8_MMA(ai, bj, At, Bt) do { __builtin_amdgcn_s_setprio(1); _Pragma("unroll") for (int m = 0; m < 4; ++m) _Pragma("unroll") for (int n = 0; n < 2; ++n) _Pragma("unroll") for (int k = 0; k < 2; ++k) \
        acc[ai][bj][m][n] = __builtin_amdgcn_mfma_f32_16x16x32_bf16(Bt[n][k], At[m][k], acc[ai][bj][m][n], 0, 0, 0); __builtin_amdgcn_s_setprio(0); } while (0)
#define PG8_WAIT_V(n) asm volatile("s_waitcnt vmcnt(" #n ")" ::: "memory")
#define PG8_WAIT_L(n) asm volatile("s_waitcnt lgkmcnt(" #n ")" ::: "memory")
#define PG8_BAR __builtin_amdgcn_s_barrier()
#define PG8_SCHED __builtin_amdgcn_sched_barrier(0)
    Unit cur, nxt; int ui = 0;
    if (!S.next(0, cur)) return;
    f32x4 acc[2][2][4][2];
#pragma unroll
    for (int a = 0; a < 2; ++a)
#pragma unroll
        for (int b = 0; b < 2; ++b)
#pragma unroll
            for (int m = 0; m < 4; ++m)
#pragma unroll
                for (int n = 0; n < 2; ++n) acc[a][b][m][n] = (f32x4){0.f, 0.f, 0.f, 0.f};
    bf16x8 At[4][2], B0[2][2], B1[2][2];
    const char* cA = (const char*)g.A + (size_t)cur.pm * tstep; const char* cB = (const char*)g.Bt + (size_t)cur.pn * tstep;
    S.a_ready(cur);
    if constexpr (SP2) {
        PG8_STAGE(PG8_SB(0, 0), cB, voffB); PG8_STAGE(PG8_SB(0, 1), cB + hstep, voffB); PG8_STAGE(PG8_SA(0, 0), cA, voffA); PG8_STAGE(PG8_SA(0, 1), cA + hstep, voffA);
        if (wr == 1) PG8_BAR;
        PG8_WAIT_V(2); PG8_BAR;
        PG8_STAGE(PG8_SB(1, 0), cB + kstep, voffB); PG8_STAGE(PG8_SA(1, 0), cA + kstep, voffA); PG8_STAGE(PG8_SB(1, 1), cB + hstep + kstep, voffB);
        PG8_WAIT_V(6); PG8_BAR;
    } else {
        PG8_STAGE(PG8_SB(0, 0), cB, voffB); PG8_STAGE(PG8_SA(0, 0), cA, voffA); PG8_STAGE(PG8_SB(0, 1), cB + hstep, voffB); PG8_STAGE(PG8_SA(0, 1), cA + hstep, voffA);
        if (wr == 1) PG8_BAR;
        PG8_WAIT_V(4); PG8_BAR;
        PG8_STAGE(PG8_SB(1, 0), cB + kstep, voffB); PG8_STAGE(PG8_SA(1, 0), cA + kstep, voffA); PG8_STAGE(PG8_SB(1, 1), cB + hstep + kstep, voffB);
        PG8_WAIT_V(6); PG8_BAR;
    }
    for (;;) {
        const bool has_next = S.next(ui + 1, nxt);
        const char* nA = has_next ? (const char*)g.A + (size_t)nxt.pm * tstep : cA; const char* nB = has_next ? (const char*)g.Bt + (size_t)nxt.pn * tstep : cB;
        for (int t = 0; t < nt; t += 2) {
            const bool last = (t == nt - 2);
            const char* a1 = cA + (size_t)(t + 1) * kstep;
            const char* a2 = last ? nA : cA + (size_t)(t + 2) * kstep; const char* b2 = last ? nB : cB + (size_t)(t + 2) * kstep;
            const char* a3 = a2 + kstep; const char* b3 = b2 + kstep;
            if (last && has_next) S.a_ready(nxt);
            if constexpr (SP2) {
            PG8_LDB(B0, 0, 0); PG8_LDB(B1, 0, 1); PG8_SCHED; PG8_LDA(At, 0, 0); PG8_STAGE(PG8_SA(1, 1), a1 + hstep, voffA);
            PG8_WAIT_V(8); PG8_WAIT_L(0); PG8_BAR; PG8_MMA(0, 0, At, B0); PG8_MMA(0, 1, At, B1); PG8_BAR; PG8_SCHED;
            PG8_LDA(At, 0, 1); PG8_STAGE(PG8_SB(0, 0), b2, voffB); PG8_STAGE(PG8_SB(0, 1), b2 + hstep, voffB); PG8_STAGE(PG8_SA(0, 0), a2, voffA);
            PG8_WAIT_V(8); PG8_WAIT_L(0); PG8_BAR; PG8_MMA(1, 0, At, B0); PG8_MMA(1, 1, At, B1); PG8_BAR; PG8_SCHED;
            PG8_LDB(B0, 1, 0); PG8_LDB(B1, 1, 1); PG8_SCHED; PG8_LDA(At, 1, 0); PG8_STAGE(PG8_SA(0, 1), a2 + hstep, voffA);
            PG8_WAIT_V(8); PG8_WAIT_L(0); PG8_BAR; PG8_MMA(0, 0, At, B0); PG8_MMA(0, 1, At, B1); PG8_BAR; PG8_SCHED;
            PG8_LDA(At, 1, 1); PG8_STAGE(PG8_SB(1, 0), b3, voffB); PG8_STAGE(PG8_SB(1, 1), b3 + hstep, voffB); PG8_STAGE(PG8_SA(1, 0), a3, voffA);
            PG8_WAIT_V(8); PG8_WAIT_L(0); PG8_BAR; PG8_MMA(1, 0, At, B0); PG8_MMA(1, 1, At, B1); PG8_BAR; PG8_SCHED;
            } else {
            PG8_LDB(B0, 0, 0); PG8_SCHED; PG8_LDA(At, 0, 0); PG8_STAGE(PG8_SA(1, 1), a1 + hstep, voffA);
            PG8_WAIT_L(8); PG8_BAR; PG8_WAIT_L(0); PG8_MMA(0, 0, At, B0); PG8_BAR; PG8_SCHED;
            PG8_LDB(B1, 0, 1); PG8_STAGE(PG8_SB(0, 0), b2, voffB);
            PG8_BAR; PG8_WAIT_L(0); PG8_MMA(0, 1, At, B1); PG8_BAR;
            PG8_LDA(At, 0, 1); PG8_STAGE(PG8_SA(0, 0), a2, voffA);
            PG8_BAR; PG8_WAIT_L(0); PG8_MMA(1, 0, At, B0); PG8_BAR; PG8_SCHED;
            PG8_STAGE(PG8_SB(0, 1), b2 + hstep, voffB);
            PG8_WAIT_V(6); PG8_BAR; PG8_MMA(1, 1, At, B1); PG8_BAR;
            PG8_LDB(B0, 1, 0); PG8_SCHED; PG8_LDA(At, 1, 0); PG8_STAGE(PG8_SA(0, 1), a2 + hstep, voffA);
            PG8_WAIT_L(8); PG8_BAR; PG8_WAIT_L(0); PG8_MMA(0, 0, At, B0); PG8_BAR; PG8_SCHED;
            PG8_LDB(B1, 1, 1); PG8_STAGE(PG8_SB(1, 0), b3, voffB);
            PG8_BAR; PG8_WAIT_L(0); PG8_MMA(0, 1, At, B1); PG8_BAR;
            PG8_LDA(At, 1, 1); PG8_STAGE(PG8_SA(1, 0), a3, voffA);
            PG8_BAR; PG8_WAIT_L(0); PG8_MMA(1, 0, At, B0); PG8_BAR; PG8_SCHED;
            PG8_STAGE(PG8_SB(1, 1), b3 + hstep, voffB);
            PG8_WAIT_V(6); PG8_BAR; PG8_MMA(1, 1, At, B1); PG8_BAR;
            }
        }
        if constexpr (ALIGN_EPI) { if (wr == 0) PG8_BAR; }
        if constexpr (!Epi::AFTER_DRAIN) { E(acc, cur, wr, wc, fr, fq); S.done(cur); }
        if (!has_next) break;
#pragma unroll
        for (int a = 0; a < 2; ++a)
#pragma unroll
            for (int b = 0; b < 2; ++b)
#pragma unroll
                for (int m = 0; m < 4; ++m)
#pragma unroll
                    for (int n = 0; n < 2; ++n) acc[a][b][m][n] = (f32x4){0.f, 0.f, 0.f, 0.f};
        cur = nxt; cA = nA; cB = nB; ++ui;
        if constexpr (ALIGN_EPI) { if (wr == 1) PG8_BAR; }
    }
    PG8_WAIT_V(0);
    if constexpr (!ALIGN_EPI) { if (wr == 0) PG8_BAR; }
    PG8_BAR;
#undef PG8_SA
#undef PG8_SB
#undef PG8_STAGE
#undef PG8_LDA
#undef PG8_LDB
#undef PG8_MMA
#undef PG8_WAIT_V
#undef PG8_WAIT_L
#undef PG8_BAR
#undef PG8_SCHED
}
}

#define LAS __attribute__((address_space(3)))
typedef unsigned short bf16;
typedef unsigned v4u __attribute__((ext_vector_type(4)));
typedef unsigned v2u __attribute__((ext_vector_type(2)));
typedef float f32x4 __attribute__((ext_vector_type(4)));
typedef float f32x16 __attribute__((ext_vector_type(16)));
typedef short bf16x8 __attribute__((ext_vector_type(8)));

constexpr int SEQ = 8192, DM = 2048, FF = 8192, NPROJ = 6144, GIN = 6160, NWAVES = 8, NTHR = 512;
constexpr float EPS = 1e-6f, LOG2E = 1.4426950408889634f;
constexpr size_t MiB = 1u << 20;
constexpr size_t WS_W1T = 16 * MiB, WS_W2T = 144 * MiB, WS_WINT = 272 * MiB, WS_WOAT = 320 * MiB, WS_WKVT = 336 * MiB, WS_WQT = 340 * MiB, WS_WOBT = 356 * MiB;
constexpr size_t WS_XN = 372 * MiB, WS_UN = 404 * MiB, WS_HB = 436 * MiB, WS_PROJ = 436 * MiB, WS_QB = 436 * MiB, WS_OB = 468 * MiB, WS_KVB = 564 * MiB, WS_Y = 580 * MiB;
constexpr size_t WS_GLR = 612 * MiB, WS_QT = 614 * MiB, WS_KTT = 630 * MiB, WS_VT = 646 * MiB, WS_G = 678 * MiB, WS_AG = 680 * MiB, WS_SLOC = 684 * MiB, WS_SINIT = 716 * MiB, WS_OG = 748 * MiB, WS_END = 813 * MiB;
constexpr int LDS_BYTES = 147456;

__device__ __forceinline__ unsigned f2bf(float f) { unsigned u = __builtin_bit_cast(unsigned, f); return (u + 0x7fffu + ((u >> 16) & 1u)) >> 16; }
typedef float f32x2_t __attribute__((ext_vector_type(2))); typedef __bf16 bf16x2_t __attribute__((ext_vector_type(2)));
__device__ __forceinline__ unsigned pk2(float lo, float hi) { f32x2_t v = {lo, hi}; bf16x2_t b = __builtin_convertvector(v, bf16x2_t); return __builtin_bit_cast(unsigned, b); }
__device__ __forceinline__ float bflo(unsigned w) { return __builtin_bit_cast(float, w << 16); }
__device__ __forceinline__ float bfhi(unsigned w) { return __builtin_bit_cast(float, w & 0xffff0000u); }
__device__ __forceinline__ float bf2f(bf16 b) { return __builtin_bit_cast(float, ((unsigned)b) << 16); }
__device__ __forceinline__ float wave_sum(float v) {
#define WS_DPP(ctrl, rmask) __builtin_bit_cast(float, __builtin_amdgcn_update_dpp(0, __builtin_bit_cast(int, v), (ctrl), (rmask), 0xF, false))
    v += WS_DPP(0xB1, 0xF);
    v += WS_DPP(0x4E, 0xF);
    v += WS_DPP(0x141, 0xF);
    v += WS_DPP(0x140, 0xF);
    v += WS_DPP(0x142, 0xA);
    v += WS_DPP(0x143, 0xC);
#undef WS_DPP
    return __builtin_bit_cast(float, __builtin_amdgcn_readlane(__builtin_bit_cast(int, v), 63));
}
__device__ __forceinline__ int crow(int r, int hi) { return (r & 3) + 8 * (r >> 2) + 4 * hi; }
__device__ __forceinline__ int swap23(int x) { return (x & ~12) | ((x & 4) << 1) | ((x & 8) >> 1); }
#define LDS_WAIT() asm volatile("s_waitcnt lgkmcnt(0)" ::: "memory")
#define MFMA32(a, b, c) __builtin_amdgcn_mfma_f32_32x32x16_bf16((a), (b), (c), 0, 0, 0)
__device__ __forceinline__ bf16x8 pack8(float a0, float a1, float a2, float a3, float a4, float a5, float a6, float a7) {
    v4u w; w.x = pg8::cvt_pk_bf16(a0, a1); w.y = pg8::cvt_pk_bf16(a2, a3); w.z = pg8::cvt_pk_bf16(a4, a5); w.w = pg8::cvt_pk_bf16(a6, a7); return __builtin_bit_cast(bf16x8, w);
}

struct Params { const float* in[18]; float* out; unsigned char* ws; };

#define XB_TMO      128
#define XB_XCNT(j)  (256  + 64 * (j))
#define XB_XSUB(j)  (1280 + 64 * (j))
#define XB_XGEN(j)  (2304 + 64 * (j))
#define XB_TOP      3328
#define XB_TOPGEN   3392
#define XCD_BAR_WORDS 3456
#define XB_SPIN_CAP (1u << 18)
__device__ __forceinline__ unsigned xb_ld(unsigned* p)              { return __hip_atomic_load(p, __ATOMIC_RELAXED, __HIP_MEMORY_SCOPE_AGENT); }
__device__ __forceinline__ unsigned xb_add(unsigned* p, unsigned v) { return __hip_atomic_fetch_add(p, v, __ATOMIC_RELAXED, __HIP_MEMORY_SCOPE_AGENT); }
__device__ __forceinline__ unsigned xb_xcc_id() { return (unsigned)__builtin_amdgcn_s_getreg((3 << 11) | 20) & 0xFu; }
#define XB_SPIN(cond, bar) do { unsigned _sp = 0; while (cond) { __builtin_amdgcn_s_sleep(1); \
    if ((++_sp & 255u) == 0u) { if (xb_ld(&(bar)[XB_TMO])) break; if (_sp > XB_SPIN_CAP) { atomicAdd(&(bar)[XB_TMO], 1u); break; } } } } while (0)
struct XcdBarrier { unsigned* bar; unsigned x; volatile LAS unsigned* st; };
__device__ __forceinline__ XcdBarrier xcd_barrier_post(unsigned* bar, volatile LAS unsigned* st) {
    XcdBarrier b; b.bar = bar; b.x = xb_xcc_id(); b.st = st;
    if (threadIdx.x == 0) (void)xb_add(&bar[XB_XCNT(b.x)], 1u);
    return b;
}
__device__ __forceinline__ void xcd_barrier_complete(unsigned* bar, unsigned x, unsigned& nloc, unsigned& nx) {
    const unsigned G = gridDim.x * gridDim.y * gridDim.z;
    unsigned sum, cnt, mine, sp = 0u;
    for (;;) {
        sum = 0u; cnt = 0u; mine = 0u;
#pragma unroll
        for (unsigned j = 0; j < 16; ++j) { const unsigned c = xb_ld(&bar[XB_XCNT(j)]); sum += c; cnt += (c > 0u) ? 1u : 0u; mine = (j == x) ? c : mine; }
        if (sum == G) break;
        __builtin_amdgcn_s_sleep(1);
        if ((++sp & 255u) == 0u) { if (xb_ld(&bar[XB_TMO])) break; if (sp > XB_SPIN_CAP) { atomicAdd(&bar[XB_TMO], 1u); break; } }
    }
    nloc = mine > 0u ? mine : 1u; nx = cnt > 0u ? cnt : 1u;
}
__device__ __forceinline__ void xcd_barrier(const XcdBarrier& b) {
    asm volatile("s_waitcnt vmcnt(0)" ::: "memory");
    __syncthreads();
    int t0_ = threadIdx.x; asm volatile("" : "+v"(t0_));
    if (t0_ == 0) {
        unsigned* bar = b.bar;
        __builtin_amdgcn_s_waitcnt(0);
        unsigned nloc = b.st[0], nx = b.st[1];
        if (nloc == 0u) { xcd_barrier_complete(bar, b.x, nloc, nx); b.st[0] = nloc; b.st[1] = nx; }
        const unsigned old = xb_add(&bar[XB_XSUB(b.x)], 1u);
        const unsigned gen = old / nloc;
        if (old + 1u == (gen + 1u) * nloc) {
            __builtin_amdgcn_fence(__ATOMIC_RELEASE, "agent");
            asm volatile("s_waitcnt vmcnt(0)" ::: "memory");
            const unsigned og = xb_add(&bar[XB_TOP], 1u);
            const unsigned tg = og / nx;
            if (og + 1u == (tg + 1u) * nx) xb_add(&bar[XB_TOPGEN], 1u);
            else XB_SPIN(xb_ld(&bar[XB_TOPGEN]) == tg, bar);
            __builtin_amdgcn_fence(__ATOMIC_ACQUIRE, "agent");
            xb_add(&bar[XB_XGEN(b.x)], 1u);
            asm volatile("s_waitcnt vmcnt(0)" ::: "memory");
        } else {
            XB_SPIN(xb_ld(&bar[XB_XGEN(b.x)]) == gen, bar);
            __builtin_amdgcn_fence(__ATOMIC_ACQUIRE, "agent");
            asm volatile("s_waitcnt vmcnt(0)" ::: "memory");
        }
    }
    __syncthreads();
}


__device__ __forceinline__ void transpose_item(const float* W, int ldw, int K, int nblk, bf16* WT, int row_off, LAS float* scr, int item, int lane, const float* gain = nullptr) {
    const int kb = item / nblk, nb = item % nblk, k0 = 64 * kb, n0 = 32 * nb;
    float wv[32];
    { const float* wp = W + (size_t)(k0 + (lane >> 5)) * ldw + n0 + (lane & 31);
#pragma unroll
      for (int i = 0; i < 32; ++i) wv[i] = wp[(size_t)(2 * i) * ldw]; }
#pragma unroll
    for (int i = 0; i < 32; ++i) scr[(2 * i + (lane >> 5)) * 33 + (lane & 31)] = wv[i];
    LDS_WAIT(); asm volatile("" ::: "memory");
    const int c = lane & 7;
    f32x4 ga = (f32x4){1.f, 1.f, 1.f, 1.f}, gb = ga;
    if (gain) { ga = *(const f32x4*)(gain + k0 + 8 * c); gb = *(const f32x4*)(gain + k0 + 8 * c + 4); }
#pragma unroll
    for (int j = 0; j < 4; ++j) { const int n = (lane >> 3) + 8 * j; const LAS float* s = scr + (8 * c) * 33 + n;
        v4u o; o.x = pk2(s[0 * 33] * ga.x, s[1 * 33] * ga.y); o.y = pk2(s[2 * 33] * ga.z, s[3 * 33] * ga.w); o.z = pk2(s[4 * 33] * gb.x, s[5 * 33] * gb.y); o.w = pk2(s[6 * 33] * gb.z, s[7 * 33] * gb.w);
        *(v4u*)(WT + (size_t)(row_off + n0 + n) * K + k0 + 8 * c) = o; }
    LDS_WAIT(); asm volatile("" ::: "memory");
}

__device__ __forceinline__ void convert_phase(const Params& p, LAS unsigned char* lds, int gw, int NGW, int wave, int lane) {
    LAS float* scr = (LAS float*)(lds + wave * 16384);
    unsigned char* ws = p.ws;
    constexpr int NITEMS = 32768 + 32768 + 12288 + 4096 + 256 + 256 + 4096 + 4096;
    for (int it = gw; it < NITEMS; it += NGW) {
        int r = it;
        if (r < 32768) { const int l = r >> 13; transpose_item(p.in[3] + (size_t)l * DM * FF, FF, DM, FF / 32, (bf16*)(ws + WS_W1T) + (size_t)l * FF * DM, 0, scr, r & 8191, lane, p.in[2] + l * DM); continue; } r -= 32768;
        if (r < 32768) { const int l = r >> 13; transpose_item(p.in[4] + (size_t)l * FF * DM, DM, FF, DM / 32, (bf16*)(ws + WS_W2T) + (size_t)l * DM * FF, 0, scr, r & 8191, lane); continue; } r -= 32768;
        if (r < 12288) { const int l = r / 6144; transpose_item(p.in[5] + (size_t)l * DM * GIN, GIN, DM, NPROJ / 32, (bf16*)(ws + WS_WINT) + (size_t)l * NPROJ * DM, 0, scr, r % 6144, lane); continue; } r -= 12288;
        if (r < 4096) { const int l = r >> 11; transpose_item(p.in[9] + (size_t)l * DM * DM, DM, DM, DM / 32, (bf16*)(ws + WS_WOAT) + (size_t)l * DM * DM, 0, scr, r & 2047, lane); continue; } r -= 4096;
        if (r < 256) { transpose_item(p.in[11], 256, DM, 8, (bf16*)(ws + WS_WKVT), 0, scr, r, lane, p.in[10]); continue; } r -= 256;
        if (r < 256) { transpose_item(p.in[12], 256, DM, 8, (bf16*)(ws + WS_WKVT), 256, scr, r, lane, p.in[10]); continue; } r -= 256;
        if (r < 4096) { const int l = r >> 11; transpose_item(p.in[14] + (size_t)l * DM * DM, DM, DM, DM / 32, (bf16*)(ws + WS_WQT) + (size_t)l * DM * DM, 0, scr, r & 2047, lane, p.in[1] + (2 + l) * DM); continue; } r -= 4096;
        { const int l = r >> 11; transpose_item(p.in[17] + (size_t)l * DM * DM, DM, DM, DM / 32, (bf16*)(ws + WS_WOBT) + (size_t)l * DM * DM, 0, scr, r & 2047, lane); }
    }
}

template <bool GLRF, bool KVN, bool IN16>
__device__ __forceinline__ void norm_phase(const float* hin, const bf16* hin16, bf16* hraw, const float* g1, bf16* XN, const float* w_in_l, float* GLRo, const float* g2, bf16* UN,
                                           LAS unsigned char* lds, int gw, int NGW, int tid, int lane) {
    LAS bf16* WgB = (LAS bf16*)lds;
    if (GLRF) {
        for (int k = tid; k < DM; k += NTHR) { const f32x4* src = (const f32x4*)(w_in_l + (size_t)k * GIN + NPROJ);
            const f32x4 a = src[0], b = src[1], c = src[2], d = src[3];
            WgB[0 * 2056 + k] = (bf16)f2bf(a.x); WgB[1 * 2056 + k] = (bf16)f2bf(a.y); WgB[2 * 2056 + k] = (bf16)f2bf(a.z); WgB[3 * 2056 + k] = (bf16)f2bf(a.w);
            WgB[4 * 2056 + k] = (bf16)f2bf(b.x); WgB[5 * 2056 + k] = (bf16)f2bf(b.y); WgB[6 * 2056 + k] = (bf16)f2bf(b.z); WgB[7 * 2056 + k] = (bf16)f2bf(b.w);
            WgB[8 * 2056 + k] = (bf16)f2bf(c.x); WgB[9 * 2056 + k] = (bf16)f2bf(c.y); WgB[10 * 2056 + k] = (bf16)f2bf(c.z); WgB[11 * 2056 + k] = (bf16)f2bf(c.w);
            WgB[12 * 2056 + k] = (bf16)f2bf(d.x); WgB[13 * 2056 + k] = (bf16)f2bf(d.y); WgB[14 * 2056 + k] = (bf16)f2bf(d.z); WgB[15 * 2056 + k] = (bf16)f2bf(d.w); }
    }
    for (int row = gw; row < SEQ; row += NGW) {
        f32x4 v[8]; float ss = 0.f;
        if (IN16) { const v2u* xr = (const v2u*)(hin16 + (size_t)row * DM) + lane;
#pragma unroll
            for (int j = 0; j < 8; ++j) { const v2u w = xr[64 * j]; v[j] = (f32x4){bflo(w.x), bfhi(w.x), bflo(w.y), bfhi(w.y)}; }
        } else { const f32x4* xr = (const f32x4*)(hin + (size_t)row * DM) + lane;
#pragma unroll
            for (int j = 0; j < 8; ++j) v[j] = xr[64 * j];
            if (hraw) { v2u* o8 = (v2u*)(hraw + (size_t)row * DM) + lane;
#pragma unroll
                for (int j = 0; j < 8; ++j) { v2u w; w.x = pk2(v[j].x, v[j].y); w.y = pk2(v[j].z, v[j].w); o8[64 * j] = w; } } }
#pragma unroll
        for (int j = 0; j < 8; ++j) ss += (v[j].x * v[j].x + v[j].y * v[j].y) + (v[j].z * v[j].z + v[j].w * v[j].w);
        const float rstd = 1.0f / sqrtf(wave_sum(ss) * (1.0f / DM) + EPS);
        if (KVN) {
            v2u* o8 = (v2u*)(UN + (size_t)row * DM) + lane;
#pragma unroll
            for (int j = 0; j < 8; ++j) { const f32x4 gg = ((const f32x4*)g2)[lane + 64 * j]; const f32x4 y = v[j] * rstd * gg; v2u w; w.x = pk2(y.x, y.y); w.y = pk2(y.z, y.w); o8[64 * j] = w; }
        }
        v2u* o8 = (v2u*)(XN + (size_t)row * DM) + lane;
#pragma unroll
        for (int j = 0; j < 8; ++j) { const f32x4 gg = ((const f32x4*)g1)[lane + 64 * j]; v[j] = v[j] * rstd * gg; v2u w; w.x = pk2(v[j].x, v[j].y); w.y = pk2(v[j].z, v[j].w); o8[64 * j] = w; }
    }
    if (GLRF) {
        __syncthreads();
        const int wave = __builtin_amdgcn_readfirstlane(tid >> 6), r32 = lane & 31, hi = lane >> 5;
        LAS float* P = (LAS float*)(lds + 65792);
        for (int i0 = 0; (long)i0 * NGW < SEQ; i0 += 4) {
            const int rowm = (gw - wave + (r32 >> 2)) + NGW * (i0 + (r32 & 3));
            const bf16* ap = XN + (size_t)(rowm < SEQ ? rowm : 0) * DM + 256 * wave + 8 * hi;
            const LAS bf16* bp = WgB + (r32 & 15) * 2056 + 256 * wave + 8 * hi;
            f32x16 acc;
#pragma unroll
            for (int r = 0; r < 16; ++r) acc[r] = 0.f;
#pragma unroll
            for (int ks = 0; ks < 16; ++ks) { const bf16x8 a = *(const bf16x8*)(ap + 16 * ks); const bf16x8 b = *(const LAS bf16x8*)(bp + 16 * ks); acc = MFMA32(a, b, acc); }
#pragma unroll
            for (int r = 0; r < 16; ++r) P[wave * 1024 + r * 64 + lane] = acc[r];
            __syncthreads();
            { const int m = tid >> 4, n = tid & 15, r = (m & 3) + 4 * (m >> 3), l2 = n + 32 * ((m >> 2) & 1); float s = 0.f;
#pragma unroll
              for (int w = 0; w < 8; ++w) s += P[w * 1024 + r * 64 + l2];
              const int rowo = (gw - wave + (m >> 2)) + NGW * (i0 + (m & 3));
              if (rowo < SEQ) GLRo[(size_t)rowo * 16 + n] = s; }
            __syncthreads();
        }
    }
}

__device__ __forceinline__ void gla_prep_unit(const Params& p, int li, int c, int h, LAS unsigned char* lds, int tid, int wave, int lane) {
    unsigned char* ws = p.ws;
    const bf16* PROJ = (const bf16*)(ws + WS_PROJ);
    const float* GLR = (const float*)(ws + WS_GLR);
    bf16* QT = (bf16*)(ws + WS_QT); bf16* KTT = (bf16*)(ws + WS_KTT); bf16* VT = (bf16*)(ws + WS_VT); bf16* AG = (bf16*)(ws + WS_AG);
    float* G = (float*)(ws + WS_G);
    LAS float* Bl = (LAS float*)lds; LAS bf16* Ql = (LAS bf16*)(lds + 65536); LAS bf16* Kl = (LAS bf16*)(lds + 99328); LAS float* T = (LAS float*)(lds + 133120);
    const int ch = c * 4 + h;
    {
        LAS bf16* Vl = (LAS bf16*)lds;
        if (tid < 256) *((LAS f32x4*)(lds + 135168) + tid) = *((const f32x4*)(GLR + (size_t)c * 64 * 16) + tid);
#pragma unroll
        for (int i = 0; i < 8; ++i) { const int it = tid + 512 * i, r = it >> 6, cg = it & 63;
            *((LAS v4u*)Vl + it) = *(const v4u*)(PROJ + ((size_t)c * 64 + r) * NPROJ + 2048 + h * 512 + 8 * cg); }
        __syncthreads();
#pragma unroll
        for (int i = 0; i < 8; ++i) { const int f = wave + 8 * i;
            const int e = (f >> 2) * 32 + (lane & 31), tok0 = (f & 3) * 16 + 8 * (lane >> 5);
            unsigned short t8[8];
#pragma unroll
            for (int j = 0; j < 8; ++j) t8[j] = Vl[(tok0 + j) * 512 + e];
            v4u o; o.x = t8[0] | ((unsigned)t8[1] << 16); o.y = t8[2] | ((unsigned)t8[3] << 16); o.z = t8[4] | ((unsigned)t8[5] << 16); o.w = t8[6] | ((unsigned)t8[7] << 16);
            *(v4u*)(VT + (size_t)ch * 32768 + (f * 64 + lane) * 8) = o; }
        __syncthreads();
    }
    {
        const int d = tid & 255, hf = wave >> 2, col = h * 256 + d;
        const float* wg2 = p.in[6] + (size_t)li * 16 * 1024; const float bias = p.in[7][li * 1024 + col];
        float w[16];
#pragma unroll
        for (int r = 0; r < 16; ++r) w[r] = wg2[r * 1024 + col];
        float cum = 0.f;
        for (int i = 0; i < 32; ++i) {
            const LAS f32x4* gp = (const LAS f32x4*)(lds + 135168) + (hf * 32 + i) * 4;
            const f32x4 g0 = gp[0], g1 = gp[1], g2 = gp[2], g3 = gp[3];
            float z = bias;
            z += g0.x * w[0] + g0.y * w[1] + g0.z * w[2] + g0.w * w[3]; z += g1.x * w[4] + g1.y * w[5] + g1.z * w[6] + g1.w * w[7];
            z += g2.x * w[8] + g2.y * w[9] + g2.z * w[10] + g2.w * w[11]; z += g3.x * w[12] + g3.y * w[13] + g3.z * w[14] + g3.w * w[15];
            const float ls = fminf(z, 0.f) - __logf(1.0f + __expf(-fabsf(z)));
            cum += ls * 0.0625f;
            Bl[(hf * 32 + i) * 256 + d] = cum;
        }
        T[hf * 256 + d] = cum;
    }
    __syncthreads();
    if (tid < 256) G[ch * 256 + tid] = __expf(T[tid] + T[256 + tid]);
#pragma unroll
    for (int i = 0; i < 4; ++i) {
        const int it = tid + 512 * i, r = it >> 5, dg = it & 31; const size_t row = (size_t)c * 64 + r;
        const v4u q8 = *(const v4u*)(PROJ + row * NPROJ + h * 256 + 8 * dg), k8 = *(const v4u*)(PROJ + row * NPROJ + 1024 + h * 256 + 8 * dg);
        f32x4 b0 = *(const LAS f32x4*)(Bl + r * 256 + 8 * dg), b1 = *(const LAS f32x4*)(Bl + r * 256 + 8 * dg + 4);
        const f32x4 t0a = *(const LAS f32x4*)(T + 8 * dg), t0b = *(const LAS f32x4*)(T + 8 * dg + 4), t1a = *(const LAS f32x4*)(T + 256 + 8 * dg), t1b = *(const LAS f32x4*)(T + 256 + 8 * dg + 4);
        if (r >= 32) { b0 = b0 + t0a; b1 = b1 + t0b; }
        const f32x4 bl0 = t0a + t1a, bl1 = t0b + t1b;
        float Bv[8] = {b0.x, b0.y, b0.z, b0.w, b1.x, b1.y, b1.z, b1.w}, BL[8] = {bl0.x, bl0.y, bl0.z, bl0.w, bl1.x, bl1.y, bl1.z, bl1.w};
        float qv[8] = {bflo(q8.x), bfhi(q8.x), bflo(q8.y), bfhi(q8.y), bflo(q8.z), bfhi(q8.z), bflo(q8.w), bfhi(q8.w)};
        float kv[8] = {bflo(k8.x), bfhi(k8.x), bflo(k8.y), bfhi(k8.y), bflo(k8.z), bfhi(k8.z), bflo(k8.w), bfhi(k8.w)};
        float qt[8], kh[8], kt[8];
#pragma unroll
        for (int j = 0; j < 8; ++j) { qt[j] = qv[j] * 0.0625f * __expf(Bv[j]); kh[j] = kv[j] * __expf(-Bv[j]); kt[j] = kv[j] * __expf(BL[j] - Bv[j]); }
        const int pbase = 16 * (dg >> 1) + 4 * (dg & 1);
        v2u w;
        w.x = pk2(qt[0], qt[1]); w.y = pk2(qt[2], qt[3]); *(LAS v2u*)(Ql + r * 264 + pbase) = w;
        w.x = pk2(qt[4], qt[5]); w.y = pk2(qt[6], qt[7]); *(LAS v2u*)(Ql + r * 264 + pbase + 8) = w;
        w.x = pk2(kh[0], kh[1]); w.y = pk2(kh[2], kh[3]); *(LAS v2u*)(Kl + r * 264 + pbase) = w;
        w.x = pk2(kh[4], kh[5]); w.y = pk2(kh[6], kh[7]); *(LAS v2u*)(Kl + r * 264 + pbase + 8) = w;
        v4u o; o.x = pk2(kt[0], kt[1]); o.y = pk2(kt[2], kt[3]); o.z = pk2(kt[4], kt[5]); o.w = pk2(kt[6], kt[7]);
        *(LAS v4u*)(Bl + r * 256 + 8 * dg) = o;
    }
    __syncthreads();
#pragma unroll
    for (int i = 0; i < 4; ++i) { const int f = wave + 8 * i, ib = f >> 4, kd = f & 15;
        const v4u v = *(const LAS v4u*)(Ql + (32 * ib + (lane & 31)) * 264 + 16 * kd + 8 * (lane >> 5));
        *(v4u*)(QT + (size_t)ch * 16384 + (f * 64 + lane) * 8) = v; }
    { const LAS bf16* Ktl = (const LAS bf16*)lds;
#pragma unroll
      for (int i = 0; i < 4; ++i) { const int f = wave + 8 * i;
        const int d = (f >> 2) * 32 + (lane & 31), tok0 = (f & 3) * 16 + 8 * (lane >> 5);
        unsigned short t8[8];
#pragma unroll
        for (int j = 0; j < 8; ++j) t8[j] = Ktl[(tok0 + j) * 512 + 16 * (d >> 3) + (d & 7)];
        v4u o; o.x = t8[0] | ((unsigned)t8[1] << 16); o.y = t8[2] | ((unsigned)t8[3] << 16); o.z = t8[4] | ((unsigned)t8[5] << 16); o.w = t8[6] | ((unsigned)t8[7] << 16);
        *(v4u*)(KTT + (size_t)ch * 16384 + (f * 64 + lane) * 8) = o; } }
    if (wave < 4) {
        const int ib = wave >> 1, jb = wave & 1, r32 = lane & 31, hi = lane >> 5;
        f32x16 acc;
#pragma unroll
        for (int r = 0; r < 16; ++r) acc[r] = 0.f;
        if (jb <= ib) {
#pragma unroll
            for (int ks = 0; ks < 16; ++ks) {
                const bf16x8 a = *(const LAS bf16x8*)(Ql + (32 * ib + r32) * 264 + 16 * ks + 8 * hi);
                const bf16x8 b = *(const LAS bf16x8*)(Kl + (32 * jb + r32) * 264 + 16 * ks + 8 * hi);
                acc = MFMA32(a, b, acc);
            }
        }
#pragma unroll
        for (int r = 0; r < 16; ++r) { const int i = 32 * ib + crow(r, hi), j = 32 * jb + r32;
            AG[((size_t)ch * 64 + i) * 64 + j] = (bf16)f2bf(j <= i ? acc[r] : 0.f); }
    }
    __syncthreads();
}

#define LBAR() asm volatile("s_waitcnt lgkmcnt(0)\n\ts_barrier" ::: "memory")
__device__ __forceinline__ void gla_state_update_lds(f32x16 (&St)[4], const LAS float* GBl, const LAS bf16* KBl, const bf16x8 (&vfr)[4], int dh, int lane, int hi) {
#pragma unroll
    for (int dt = 0; dt < 4; ++dt)
#pragma unroll
        for (int rg = 0; rg < 4; ++rg) { const f32x4 gv = *(const LAS f32x4*)(GBl + 128 * dh + 32 * dt + 8 * rg + 4 * hi);
            St[dt][4 * rg + 0] *= gv.x; St[dt][4 * rg + 1] *= gv.y; St[dt][4 * rg + 2] *= gv.z; St[dt][4 * rg + 3] *= gv.w; }
#pragma unroll
    for (int ks = 0; ks < 4; ++ks)
#pragma unroll
        for (int dt = 0; dt < 4; ++dt) { const bf16x8 afr = *(const LAS bf16x8*)(KBl + ((((4 * dh + dt) * 4 + ks) * 64) + lane) * 8); St[dt] = MFMA32(afr, vfr[ks], St[dt]); }
}

__device__ __forceinline__ void gla_s1_unit(const Params& p, int s, int h, int sl, LAS unsigned char* lds, int tid, int wave, int lane) {
    unsigned char* ws = p.ws;
    const bf16* KTT = (const bf16*)(ws + WS_KTT); const bf16* VT = (const bf16*)(ws + WS_VT); const float* G = (const float*)(ws + WS_G);
    float* SLOC = (float*)(ws + WS_SLOC);
    const int dh = wave >> 2, eb = wave & 3, r32 = lane & 31, hi = lane >> 5, e0 = 128 * sl + 32 * eb;
    f32x16 St[4];
#pragma unroll
    for (int dt = 0; dt < 4; ++dt)
#pragma unroll
        for (int r = 0; r < 16; ++r) St[dt][r] = 0.f;
    v4u pk[4]; float pg = 0.f, gprod = 1.f;
    { const int ch = (s * 8) * 4 + h; const v4u* kp = (const v4u*)(KTT + (size_t)ch * 16384) + tid;
#pragma unroll
      for (int i = 0; i < 4; ++i) pk[i] = kp[512 * i];
      if (tid < 256) pg = G[(size_t)ch * 256 + tid]; }
    bf16x8 vnx[4];
#pragma unroll
    for (int ks = 0; ks < 4; ++ks) vnx[ks] = *(const bf16x8*)(VT + (size_t)((s * 8) * 4 + h) * 32768 + (((e0 >> 5) * 4 + ks) * 64 + lane) * 8);
#pragma unroll 1
    for (int cc = 0; cc < 8; ++cc) {
        const int ch = (s * 8 + cc) * 4 + h, cur = cc & 1;
        LAS bf16* KBl = (LAS bf16*)(lds + cur * 32768); LAS float* GBl = (LAS float*)(lds + 65536 + cur * 1024);
        gprod *= (tid < 256) ? pg : 1.f;
        bf16x8 vfr[4];
#pragma unroll
        for (int ks = 0; ks < 4; ++ks) vfr[ks] = vnx[ks];
        if (cc < 7) {
#pragma unroll
            for (int ks = 0; ks < 4; ++ks) vnx[ks] = *(const bf16x8*)(VT + (size_t)(ch + 4) * 32768 + (((e0 >> 5) * 4 + ks) * 64 + lane) * 8); }
#pragma unroll
        for (int i = 0; i < 4; ++i) *((LAS v4u*)KBl + tid + 512 * i) = pk[i];
        if (tid < 256) GBl[tid] = pg;
        LBAR();
        if (cc < 7) { const int chn = ch + 4; const v4u* kp = (const v4u*)(KTT + (size_t)chn * 16384) + tid;
#pragma unroll
            for (int i = 0; i < 4; ++i) pk[i] = kp[512 * i];
            if (tid < 256) pg = G[(size_t)chn * 256 + tid]; }
        gla_state_update_lds(St, GBl, KBl, vfr, dh, lane, hi);
    }
#pragma unroll
    for (int dt = 0; dt < 4; ++dt)
#pragma unroll
        for (int r = 0; r < 16; ++r) SLOC[((size_t)(s * 4 + h) * 256 + 128 * dh + 32 * dt + crow(r, hi)) * 512 + e0 + r32] = St[dt][r];
    if (sl == 0 && tid < 256) ((float*)(ws + WS_G + MiB))[(s * 4 + h) * 256 + tid] = gprod;
    LBAR();
}

__device__ __forceinline__ void gla_s2_phase(const Params& p, int gtid) {
    unsigned char* ws = p.ws;
    const float* GSEG = (const float*)(ws + WS_G + MiB); const f32x4* SLOC = (const f32x4*)(ws + WS_SLOC); f32x4* SINIT = (f32x4*)(ws + WS_SINIT);
    const int h = gtid >> 15, d = (gtid >> 7) & 255;
    float gs[15]; f32x4 sl[15];
#pragma unroll
    for (int s = 0; s < 15; ++s) { gs[s] = GSEG[(s * 4 + h) * 256 + d]; sl[s] = SLOC[(size_t)s * 131072 + gtid]; }
    f32x4 cur = (f32x4){0.f, 0.f, 0.f, 0.f};
#pragma unroll
    for (int s = 0; s < 16; ++s) {
        SINIT[(size_t)s * 131072 + gtid] = cur;
        if (s < 15) cur = cur * gs[s] + sl[s];
    }
}

__device__ __forceinline__ void gla_s3_unit(const Params& p, int s, int h, int sl, LAS unsigned char* lds, int tid, int wave, int lane) {
    unsigned char* ws = p.ws;
    const bf16* QT = (const bf16*)(ws + WS_QT); const bf16* KTT = (const bf16*)(ws + WS_KTT); const bf16* VT = (const bf16*)(ws + WS_VT); const bf16* AG = (const bf16*)(ws + WS_AG);
    const float* G = (const float*)(ws + WS_G); const float* SINIT = (const float*)(ws + WS_SINIT); bf16* OG = (bf16*)(ws + WS_OG);
    const int dh = wave >> 2, eb = wave & 3, r32 = lane & 31, hi = lane >> 5, e0 = 128 * sl + 32 * eb;
    LAS bf16* KBl = (LAS bf16*)(lds + 65536); LAS float* X = (LAS float*)(lds + 98304); LAS float* GBl = (LAS float*)(lds + 131072);
    v4u pq[4], pk[4]; float pg = 0.f;
    { const int ch = (s * 8) * 4 + h; const v4u* qp = (const v4u*)(QT + (size_t)ch * 16384) + tid; const v4u* kp = (const v4u*)(KTT + (size_t)ch * 16384) + tid;
#pragma unroll
      for (int i = 0; i < 4; ++i) { pq[i] = qp[512 * i]; pk[i] = kp[512 * i]; }
      if (tid < 256) pg = G[(size_t)ch * 256 + tid]; }
    f32x16 St[4];
#pragma unroll
    for (int dt = 0; dt < 4; ++dt)
#pragma unroll
        for (int r = 0; r < 16; ++r) St[dt][r] = SINIT[((size_t)(s * 4 + h) * 256 + 128 * dh + 32 * dt + crow(r, hi)) * 512 + e0 + r32];
#pragma unroll
    for (int i = 0; i < 4; ++i) *((LAS v4u*)lds + tid + 512 * i) = pq[i];
    LBAR();
#pragma unroll 1
    for (int cc = 0; cc < 8; ++cc) {
        const int c = s * 8 + cc, ch = c * 4 + h, cur = cc & 1;
        const LAS bf16* QBl = (const LAS bf16*)(lds + cur * 32768);
        bf16x8 afr[4], vfr[4];
#pragma unroll
        for (int ks = 0; ks < 4; ++ks) {
            afr[ks] = *(const bf16x8*)(AG + ((size_t)ch * 64 + 32 * dh + r32) * 64 + 16 * ks + 8 * hi);
            vfr[ks] = *(const bf16x8*)(VT + (size_t)ch * 32768 + (((e0 >> 5) * 4 + ks) * 64 + lane) * 8); }
        if (cc < 7) { const v4u* qp = (const v4u*)(QT + (size_t)(ch + 4) * 16384) + tid;
#pragma unroll
            for (int i = 0; i < 4; ++i) pq[i] = qp[512 * i]; }
        f32x16 op0, op1;
#pragma unroll
        for (int r = 0; r < 16; ++r) { op0[r] = 0.f; op1[r] = 0.f; }
#pragma unroll
        for (int dt = 0; dt < 4; ++dt)
#pragma unroll
            for (int ss = 0; ss < 2; ++ss) {
                const bf16x8 sb = pack8(St[dt][8 * ss + 0], St[dt][8 * ss + 1], St[dt][8 * ss + 2], St[dt][8 * ss + 3], St[dt][8 * ss + 4], St[dt][8 * ss + 5], St[dt][8 * ss + 6], St[dt][8 * ss + 7]);
                const LAS bf16* qp = QBl + ((8 * dh + 2 * dt + ss) * 64 + lane) * 8;
                const bf16x8 q0 = *(const LAS bf16x8*)qp; const bf16x8 q1 = *(const LAS bf16x8*)(qp + 16 * 512);
                op0 = MFMA32(q0, sb, op0); op1 = MFMA32(q1, sb, op1);
            }
        f32x16 keep, send;
#pragma unroll
        for (int r = 0; r < 16; ++r) { keep[r] = dh ? op1[r] : op0[r]; send[r] = dh ? op0[r] : op1[r]; }
        { LAS float* xd = X + ((1 - dh) * 4 + eb) * 1024 + lane;
#pragma unroll
          for (int r = 0; r < 16; ++r) xd[r * 64] = send[r]; }
#pragma unroll
        for (int i = 0; i < 4; ++i) *((LAS v4u*)KBl + tid + 512 * i) = pk[i];
        if (tid < 256) GBl[tid] = pg;
        LBAR();
        { const LAS float* xs = X + wave * 1024 + lane;
#pragma unroll
          for (int r = 0; r < 16; ++r) keep[r] += xs[r * 64]; }
        if (cc < 7) { const v4u* kp = (const v4u*)(KTT + (size_t)(ch + 4) * 16384) + tid;
#pragma unroll
            for (int i = 0; i < 4; ++i) pk[i] = kp[512 * i];
            if (tid < 256) pg = G[(size_t)(ch + 4) * 256 + tid]; }
#pragma unroll
        for (int ks = 0; ks < 4; ++ks) keep = MFMA32(afr[ks], vfr[ks], keep);
#pragma unroll
        for (int r = 0; r < 16; ++r) OG[((size_t)c * 64 + 32 * dh + crow(r, hi)) * DM + h * 512 + e0 + r32] = (bf16)f2bf(keep[r]);
        gla_state_update_lds(St, GBl, KBl, vfr, dh, lane, hi);
        if (cc < 7) {
#pragma unroll
            for (int i = 0; i < 4; ++i) *((LAS v4u*)(lds + (cur ^ 1) * 32768) + tid + 512 * i) = pq[i]; }
        LBAR();
    }
}

__device__ __forceinline__ void gla_post_phase(const Params& p, int li, int gw, int NGW, int lane) {
    unsigned char* ws = p.ws;
    const bf16* OG = (const bf16*)(ws + WS_OG); const bf16* PROJ = (const bf16*)(ws + WS_PROJ); bf16* Y = (bf16*)(ws + WS_Y);
    const float* go = p.in[8] + li * 512;
    const f32x4 ga = *(const f32x4*)(go + 8 * lane), gb = *(const f32x4*)(go + 8 * lane + 4);
    for (int row = gw; row < SEQ; row += NGW) {
#pragma unroll
        for (int hh = 0; hh < 4; ++hh) {
            const v4u ow = *(const v4u*)(OG + (size_t)row * DM + hh * 512 + 8 * lane);
            const f32x4 a = (f32x4){bflo(ow.x), bfhi(ow.x), bflo(ow.y), bfhi(ow.y)}, b = (f32x4){bflo(ow.z), bfhi(ow.z), bflo(ow.w), bfhi(ow.w)};
            float ss = (a.x * a.x + a.y * a.y) + (a.z * a.z + a.w * a.w) + (b.x * b.x + b.y * b.y) + (b.z * b.z + b.w * b.w);
            const float rstd = 1.0f / sqrtf(wave_sum(ss) * (1.0f / 512.f) + EPS);
            const v4u rr = *(const v4u*)(PROJ + (size_t)row * NPROJ + 4096 + hh * 512 + 8 * lane);
            float rv[8] = {bflo(rr.x), bfhi(rr.x), bflo(rr.y), bfhi(rr.y), bflo(rr.z), bfhi(rr.z), bflo(rr.w), bfhi(rr.w)};
            float yv[8] = {a.x * ga.x, a.y * ga.y, a.z * ga.z, a.w * ga.w, b.x * gb.x, b.y * gb.y, b.z * gb.z, b.w * gb.w};
#pragma unroll
            for (int k = 0; k < 8; ++k) yv[k] = yv[k] * rstd * (rv[k] * __builtin_amdgcn_rcpf(1.0f + __expf(-rv[k])));
            v4u o; o.x = pk2(yv[0], yv[1]); o.y = pk2(yv[2], yv[3]); o.z = pk2(yv[4], yv[5]); o.w = pk2(yv[6], yv[7]);
            *(v4u*)(Y + (size_t)row * DM + hh * 512 + 8 * lane) = o;
        }
    }
}

__device__ __forceinline__ void attn_unit(const Params& p, int lj, int nb, int kh, LAS unsigned char* lds, int tid, int wave, int lane) {
    unsigned char* ws = p.ws;
    const bf16* Q = (const bf16*)(ws + WS_QB); const bf16* KV = (const bf16*)(ws + WS_KVB); bf16* O = (bf16*)(ws + WS_OB);
    const float* gq = p.in[15] + lj * 64; const float* gk = p.in[13]; const float* sinks = p.in[16] + lj * 32;
    LAS bf16* Kl = (LAS bf16*)lds; LAS bf16* VTl = (LAS bf16*)(lds + 36864);
    {
        const int key = tid >> 1, half = tid & 1; const int grow = 128 * (nb - 1) + key;
        v4u kr[4], vr[4];
        if (grow >= 0) {
            const v4u* kp = (const v4u*)(KV + (size_t)grow * 512 + kh * 64 + 32 * half); const v4u* vp = (const v4u*)(KV + (size_t)grow * 512 + 256 + kh * 64 + 32 * half);
#pragma unroll
            for (int i = 0; i < 4; ++i) { kr[i] = kp[i]; vr[i] = vp[i]; }
        } else {
#pragma unroll
            for (int i = 0; i < 4; ++i) { kr[i] = (v4u){0u, 0u, 0u, 0u}; vr[i] = (v4u){0u, 0u, 0u, 0u}; }
        }
        float kf[32]; float ss = 0.f;
#pragma unroll
        for (int i = 0; i < 4; ++i)
#pragma unroll
            for (int j = 0; j < 4; ++j) { const unsigned w = kr[i][j]; kf[8 * i + 2 * j] = bflo(w); kf[8 * i + 2 * j + 1] = bfhi(w); }
#pragma unroll
        for (int i = 0; i < 32; ++i) ss += kf[i] * kf[i];
        ss += __shfl_xor(ss, 1);
        const float sc = 1.0f / sqrtf(ss * (1.0f / 64.f) + EPS);
#pragma unroll
        for (int i = 0; i < 32; ++i) kf[i] = kf[i] * sc * gk[32 * half + i];
#pragma unroll
        for (int i = 0; i < 4; ++i) { v4u o; o.x = pk2(kf[8 * i], kf[8 * i + 1]); o.y = pk2(kf[8 * i + 2], kf[8 * i + 3]); o.z = pk2(kf[8 * i + 4], kf[8 * i + 5]); o.w = pk2(kf[8 * i + 6], kf[8 * i + 7]);
            *(LAS v4u*)(Kl + key * 72 + 32 * half + 8 * i) = o; }
        const int pos = (key & ~15) | swap23(key & 15);
#pragma unroll
        for (int i = 0; i < 4; ++i)
#pragma unroll
            for (int j = 0; j < 4; ++j) { const unsigned w = vr[i][j];
                VTl[(32 * half + 8 * i + 2 * j) * 264 + pos] = (bf16)(w & 0xffffu); VTl[(32 * half + 8 * i + 2 * j + 1) * 264 + pos] = (bf16)(w >> 16); }
    }
    __syncthreads();
    const int r32 = lane & 31, hi = lane >> 5, qh = kh * 8 + wave;
    const float sink2 = sinks[qh] * LOG2E;
    float gqv[4][8];
#pragma unroll
    for (int ks = 0; ks < 4; ++ks)
#pragma unroll
        for (int j = 0; j < 8; ++j) gqv[ks][j] = gq[16 * ks + 8 * hi + j];
#pragma unroll 1
    for (int qb = 0; qb < 4; ++qb) {
        const size_t row = (size_t)128 * nb + 32 * qb + r32;
        const bf16* qp = Q + row * DM + qh * 64 + 8 * hi;
        float qf[4][8]; float ss = 0.f;
#pragma unroll
        for (int ks = 0; ks < 4; ++ks) { const v4u w = *(const v4u*)(qp + 16 * ks);
#pragma unroll
            for (int j = 0; j < 4; ++j) { qf[ks][2 * j] = bflo(w[j]); qf[ks][2 * j + 1] = bfhi(w[j]); } }
#pragma unroll
        for (int ks = 0; ks < 4; ++ks)
#pragma unroll
            for (int j = 0; j < 8; ++j) ss += qf[ks][j] * qf[ks][j];
        ss += __shfl_xor(ss, 32);
        const float rs = (1.0f / sqrtf(ss * (1.0f / 64.f) + EPS)) * 0.125f * LOG2E;
        bf16x8 qfr[4];
#pragma unroll
        for (int ks = 0; ks < 4; ++ks) qfr[ks] = pack8(qf[ks][0] * rs * gqv[ks][0], qf[ks][1] * rs * gqv[ks][1], qf[ks][2] * rs * gqv[ks][2], qf[ks][3] * rs * gqv[ks][3],
                                                        qf[ks][4] * rs * gqv[ks][4], qf[ks][5] * rs * gqv[ks][5], qf[ks][6] * rs * gqv[ks][6], qf[ks][7] * rs * gqv[ks][7]);
        f32x16 sc[5];
#pragma unroll
        for (int t = 0; t < 5; ++t) {
#pragma unroll
            for (int r = 0; r < 16; ++r) sc[t][r] = 0.f;
#pragma unroll
            for (int ks = 0; ks < 4; ++ks) { const bf16x8 kfr = *(const LAS bf16x8*)(Kl + (32 * (qb + t) + r32) * 72 + 16 * ks + 8 * hi); sc[t] = MFMA32(kfr, qfr[ks], sc[t]); }
        }
        const int qi = 32 * qb + r32; float m = sink2;
#pragma unroll
        for (int t = 0; t < 5; ++t)
#pragma unroll
            for (int r = 0; r < 16; ++r) { const int kj = 32 * (qb + t) + crow(r, hi); const int rel = qi + 128 - kj;
                const bool valid = (rel >= 0) && (rel < 128) && (nb > 0 || kj >= 128);
                sc[t][r] = valid ? sc[t][r] : -INFINITY; m = fmaxf(m, sc[t][r]); }
        m = fmaxf(m, __shfl_xor(m, 32));
        float l = 0.f;
#pragma unroll
        for (int t = 0; t < 5; ++t)
#pragma unroll
            for (int r = 0; r < 16; ++r) { const float pe = __builtin_amdgcn_exp2f(sc[t][r] - m); sc[t][r] = pe; l += pe; }
        l += __shfl_xor(l, 32); l += __builtin_amdgcn_exp2f(sink2 - m);
        f32x16 ot0, ot1;
#pragma unroll
        for (int r = 0; r < 16; ++r) { ot0[r] = 0.f; ot1[r] = 0.f; }
#pragma unroll
        for (int t = 0; t < 5; ++t)
#pragma unroll
            for (int s = 0; s < 2; ++s) {
                const bf16x8 pf = pack8(sc[t][8 * s + 0], sc[t][8 * s + 1], sc[t][8 * s + 2], sc[t][8 * s + 3], sc[t][8 * s + 4], sc[t][8 * s + 5], sc[t][8 * s + 6], sc[t][8 * s + 7]);
                const LAS bf16* vp = VTl + r32 * 264 + 32 * (qb + t) + 16 * s + 8 * hi;
                const bf16x8 v0 = *(const LAS bf16x8*)vp; const bf16x8 v1 = *(const LAS bf16x8*)(vp + 32 * 264);
                ot0 = MFMA32(v0, pf, ot0); ot1 = MFMA32(v1, pf, ot1);
            }
        const float inv = 1.0f / l;
        bf16* orow = O + row * DM + qh * 64 + 4 * hi;
#pragma unroll
        for (int rg = 0; rg < 4; ++rg) {
            v2u w0; w0.x = pk2(ot0[4 * rg] * inv, ot0[4 * rg + 1] * inv); w0.y = pk2(ot0[4 * rg + 2] * inv, ot0[4 * rg + 3] * inv); *(v2u*)(orow + 8 * rg) = w0;
            v2u w1; w1.x = pk2(ot1[4 * rg] * inv, ot1[4 * rg + 1] * inv); w1.y = pk2(ot1[4 * rg + 2] * inv, ot1[4 * rg + 3] * inv); *(v2u*)(orow + 32 + 8 * rg) = w1;
        }
    }
    __syncthreads();
}

__global__ void __launch_bounds__(NTHR, 2) yoco_fwd(Params p) {
    __shared__ __attribute__((aligned(16))) unsigned char lds_raw[LDS_BYTES];
    LAS unsigned char* lds = (LAS unsigned char*)lds_raw;
    cg::grid_group grid = cg::this_grid();
#ifndef REP_GLA
#define REP_GLA 1
#endif
#ifndef REP_CONV
#define REP_CONV 1
#endif
#ifndef EXTRA_SYNC
#define EXTRA_SYNC 0
#endif
#ifndef REP_NORM
#define REP_NORM 1
#endif
#ifndef CUT
#define CUT 1000
#endif
#define PHC() do { if (phc++ >= CUT) return; } while (0)
#define PWS() Params q = p; int bxq = blockIdx.x; asm volatile("" : "+s"(q.ws), "+s"(q.out), "+s"(bxq))
#define TIDS() int tid = threadIdx.x; asm volatile("" : "+v"(tid)); const int lane = tid & 63, wave = __builtin_amdgcn_readfirstlane(tid >> 6); const int gw = vcu * NWAVES + wave
    const int G = gridDim.x, bx = blockIdx.x; int phc = 0;
    volatile LAS unsigned* bst = (volatile LAS unsigned*)(lds + LDS_BYTES - 64);
    if (threadIdx.x < 2) bst[threadIdx.x] = 0u;
    __syncthreads();
    const XcdBarrier xbar = xcd_barrier_post((unsigned*)p.ws + 1024, bst);
#define GSYNC() xcd_barrier(xbar)
    const int vcu = (G % 8 == 0) ? (bx % 8) * (G / 8) + bx / 8 : bx;
    const int NGW = G * NWAVES;
    { PHC(); PWS(); TIDS(); convert_phase(q, lds, gw, NGW, wave, lane); }
    __syncthreads();
    { PHC(); PWS(); TIDS(); norm_phase<true, false, false>(q.in[0], nullptr, ((bf16*)(q.ws + WS_UN)), q.in[1], ((bf16*)(q.ws + WS_XN)), q.in[5], ((float*)(q.ws + WS_GLR)), nullptr, nullptr, lds, gw, NGW, tid, lane); }
    GSYNC();
    if (p.ws == nullptr) grid.sync();
#pragma unroll 1
    for (int layer = 0; layer < 4; ++layer) {

        if (layer < 2) {
            if (layer == 1) {
                { PHC(); PWS(); TIDS(); norm_phase<true, false, true>(nullptr, ((const bf16*)(q.ws + WS_UN)), nullptr, q.in[1] + layer * DM, ((bf16*)(q.ws + WS_XN)), q.in[5] + (size_t)layer * DM * GIN, ((float*)(q.ws + WS_GLR)), nullptr, nullptr, lds, gw, NGW, tid, lane); }
                GSYNC();
            }
            { PHC(); PWS(); pg8::Gemm g{((bf16*)(q.ws + WS_XN)), (const bf16*)(q.ws + WS_WINT) + (size_t)layer * NPROJ * DM, SEQ, NPROJ, DM}; pg8::StaticOrder S; S.init(SEQ, NPROJ, G, bxq);
              pg8::EpiBf16<0, false> E{(bf16*)(q.ws + WS_PROJ), NPROJ, nullptr};
              pg8::gemm_phase<pg8::EpiBf16<0, false>, pg8::StaticOrder, true, true>(lds, g, S, E); }
            GSYNC();
            { PHC(); PWS(); TIDS(); (void)gw; for (int u = bxq; u < 512; u += G) gla_prep_unit(q, layer, u >> 2, u & 3, lds, tid, wave, lane); }
            GSYNC();
            { PHC(); PWS(); TIDS(); (void)gw; for (int u = vcu; u < 240; u += G) gla_s1_unit(q, u >> 4, (u >> 2) & 3, u & 3, lds, tid, wave, lane); }
            GSYNC();
            { PHC(); PWS(); TIDS(); (void)gw; (void)lane; for (int gt = bxq * NTHR + tid; gt < 131072; gt += G * NTHR) gla_s2_phase(q, gt); }
            GSYNC();
            { PHC(); PWS(); TIDS(); (void)gw; for (int u = vcu; u < 256; u += G) gla_s3_unit(q, u >> 4, (u >> 2) & 3, u & 3, lds, tid, wave, lane); }
            GSYNC();
            { PHC(); PWS(); TIDS(); gla_post_phase(q, layer, gw, NGW, lane); }
            GSYNC();
            { PHC(); PWS(); pg8::Gemm g{(const bf16*)(q.ws + WS_Y), (const bf16*)(q.ws + WS_WOAT) + (size_t)layer * DM * DM, SEQ, DM, DM}; pg8::StaticOrder S; S.init(SEQ, DM, G, bxq);
              pg8::EpiRes<false> E{((bf16*)(q.ws + WS_UN)), nullptr, DM, ((float*)(q.ws + 613 * MiB)), nullptr};
              pg8::gemm_phase<pg8::EpiRes<false>, pg8::StaticOrder, true, true>(lds, g, S, E); }
            GSYNC();
        } else {
            const int lj = layer - 2;
            { PHC(); PWS(); pg8::Gemm g{((bf16*)(q.ws + WS_UN)), (const bf16*)(q.ws + WS_WQT) + (size_t)lj * DM * DM, SEQ, DM, DM}; pg8::StaticOrder S; S.init(SEQ, DM, G, bxq);
              pg8::EpiBf16<0, false> E{(bf16*)(q.ws + WS_QB), DM, nullptr};
              pg8::gemm_phase<pg8::EpiBf16<0, false>, pg8::StaticOrder, true, true>(lds, g, S, E); }
            if (layer == 2) {
              PHC(); PWS(); pg8::Gemm g{((bf16*)(q.ws + WS_UN)), (const bf16*)(q.ws + WS_WKVT), SEQ, 512, DM}; pg8::StaticOrder S; S.init(SEQ, 512, G, bxq);
              pg8::EpiBf16<0, true> E{(bf16*)(q.ws + WS_KVB), 512, ((float*)(q.ws + 812 * MiB))};
              pg8::gemm_phase<pg8::EpiBf16<0, true>, pg8::StaticOrder, true, true>(lds, g, S, E); }
            GSYNC();
            { PHC(); PWS(); TIDS(); (void)gw; for (int u = vcu; u < 256; u += G) attn_unit(q, lj, u >> 2, u & 3, lds, tid, wave, lane); }
            GSYNC();
            { PHC(); PWS(); pg8::Gemm g{(const bf16*)(q.ws + WS_OB), (const bf16*)(q.ws + WS_WOBT) + (size_t)lj * DM * DM, SEQ, DM, DM}; pg8::StaticOrder S; S.init(SEQ, DM, G, bxq);
              pg8::EpiRes<false> E{((bf16*)(q.ws + WS_UN)), nullptr, DM, ((float*)(q.ws + 613 * MiB)), nullptr};
              pg8::gemm_phase<pg8::EpiRes<false>, pg8::StaticOrder, true, true>(lds, g, S, E); }
            GSYNC();
        }
        { PHC(); PWS(); pg8::Gemm g{((bf16*)(q.ws + WS_UN)), (const bf16*)(q.ws + WS_W1T) + (size_t)layer * FF * DM, SEQ, FF, DM}; pg8::StaticOrder S; S.init(SEQ, FF, G, bxq);
          pg8::EpiBf16<2, false> E{((bf16*)(q.ws + WS_HB)), FF, nullptr};
          pg8::gemm_phase<pg8::EpiBf16<2, false>, pg8::StaticOrder, true, true>(lds, g, S, E); }
        GSYNC();
        if (layer < 3) { PHC(); PWS(); pg8::Gemm g{((bf16*)(q.ws + WS_HB)), (const bf16*)(q.ws + WS_W2T) + (size_t)layer * DM * FF, SEQ, DM, FF}; pg8::StaticOrder S; S.init(SEQ, DM, G, bxq);
          pg8::EpiRes<false> E{((bf16*)(q.ws + WS_UN)), nullptr, DM, ((float*)(q.ws + 812 * MiB)), ((const float*)(q.ws + 613 * MiB))};
          pg8::gemm_phase<pg8::EpiRes<false>, pg8::StaticOrder, true, true>(lds, g, S, E); }
        else { PHC(); PWS(); pg8::Gemm g{((bf16*)(q.ws + WS_HB)), (const bf16*)(q.ws + WS_W2T) + (size_t)layer * DM * FF, SEQ, DM, FF}; pg8::StaticOrder S; S.init(SEQ, DM, G, bxq);
          pg8::EpiRes<true> E{((bf16*)(q.ws + WS_UN)), q.out, DM, nullptr, ((const float*)(q.ws + 613 * MiB))};
          pg8::gemm_phase<pg8::EpiRes<true>, pg8::StaticOrder, true, true>(lds, g, S, E); }
        GSYNC();
    }
}

extern "C" void kernel_launch(void* const* d_in, const int* in_sizes, int n_in, void* d_out, int out_size, void* d_ws, size_t ws_size, hipStream_t stream) {
    static int grid = 0;
    if (grid == 0) {
        if (n_in != 18 || out_size != SEQ * DM || ws_size < WS_END) { fprintf(stderr, "kernel_launch: unexpected shapes (n_in %d out %d ws %zu)\n", n_in, out_size, ws_size); grid = -1; return; }
        int dev = 0, cus = 0, per_cu = 0;
        hipGetDevice(&dev); hipDeviceGetAttribute(&cus, hipDeviceAttributeMultiprocessorCount, dev);
        hipOccupancyMaxActiveBlocksPerMultiprocessor(&per_cu, (const void*)yoco_fwd, NTHR, 0);
        (void)hipGetLastError();
        if (per_cu < 1) per_cu = 1;
        grid = cus;
        if (grid > 256) grid = 256;
    }
    if (grid < 0) return;
    if (hipMemsetAsync(d_ws, 0, 65536, stream) != hipSuccess) { fprintf(stderr, "kernel_launch: memset failed\n"); return; }
    Params p{};
    for (int i = 0; i < 18; ++i) p.in[i] = (const float*)d_in[i];
    p.out = (float*)d_out; p.ws = (unsigned char*)d_ws;
    void* args[] = {&p};
    hipError_t e = hipLaunchCooperativeKernel((const void*)yoco_fwd, dim3(grid), dim3(NTHR), args, 0, stream);
    if (e != hipSuccess) fprintf(stderr, "cooperative launch failed: %s (grid %d)\n", hipGetErrorString(e), grid);
}
```

```cpp
#include <hip/hip_runtime.h>
#include <hip/hip_cooperative_groups.h>
#include <cstdio>
#include <cstdint>
namespace cg = cooperative_groups;

namespace pg8 {
#define PG8_LAS __attribute__((address_space(3)))
typedef unsigned short bf16_t;
typedef short bf16x8 __attribute__((ext_vector_type(8)));
typedef float f32x4 __attribute__((ext_vector_type(4)));
typedef unsigned u32x4 __attribute__((ext_vector_type(4)));
constexpr int BM = 256, BK = 64, HALF = 128, HTB = HALF * BK * 2, STAGE_BYTES = 8 * HTB, NXCD = 8, WGM = 8;

__host__ __device__ __forceinline__ int lds_byte(int r, int c) { const int st = (r >> 4) * 2 + (c >> 5), rr = r & 15, cc = c & 31, ob = rr * 64 + cc * 2; return st * 1024 + (ob ^ (((ob >> 9) & 1) << 5)); }
__host__ __device__ __forceinline__ void stage_rc(int b, int& R, int& C) { const int st = b / 1024, sb = b % 1024, swz = sb ^ (((sb >> 9) & 1) << 5); R = (st >> 1) * 16 + swz / 64; C = (st & 1) * 32 + (swz % 64) / 2; }
__host__ __device__ __forceinline__ int perm32(int rho) { const int n = rho >> 4, i = rho & 15; return 8 * (i >> 2) + 4 * n + (i & 3); }

struct Unit { int pm, pn; };
struct Gemm { const bf16_t* A; const bf16_t* Bt; int M, N, K; };

struct StaticOrder {
    int nM, nN, nwg, G, c;
    __host__ __device__ void init(int M, int N, int G_, int c_) { nM = M / BM; nN = N / BM; nwg = nM * nN; G = G_; c = c_; }
    __host__ __device__ bool next(int i, Unit& u) const {
        const long L = (long)i * G + c; if (L >= nwg) return false;
        int wgid = (int)L; { const int q = nwg / NXCD, r = nwg % NXCD, xcd = wgid % NXCD, off = wgid / NXCD; wgid = (xcd < r ? xcd * (q + 1) : r * (q + 1) + (xcd - r) * q) + off; }
        const int nig = WGM * nN, gid = wgid / nig, fm = gid * WGM, gsz = (nM - fm) < WGM ? (nM - fm) : WGM;
        u.pm = fm + ((wgid % nig) % gsz); u.pn = (wgid % nig) / gsz; return true;
    }
    __device__ __forceinline__ void a_ready(const Unit&) const {}
    __device__ __forceinline__ void done(const Unit&) const {}
};

__device__ __forceinline__ unsigned cvt_pk_bf16(float lo, float hi) { unsigned r; asm volatile("v_cvt_pk_bf16_f32 %0, %1, %2" : "=v"(r) : "v"(lo), "v"(hi)); return r; }

template <int ACT, bool RS> struct EpiBf16 {
    static constexpr bool PERM = true, AFTER_DRAIN = false;
    bf16_t* O; int ldc; const float* ssq;
    __device__ __forceinline__ void operator()(const f32x4 (&acc)[2][2][4][2], const Unit& u, int wr, int wc, int fr, int fq) const {
        const int row0 = u.pm * BM + wr * 64 + fr; const int col0 = u.pn * BM + wc * 32 + 8 * fq;
#pragma unroll
        for (int ai = 0; ai < 2; ++ai)
#pragma unroll
            for (int m = 0; m < 4; ++m) { const int row = row0 + ai * HALF + m * 16; bf16_t* rowp = O + (size_t)row * ldc + col0;
                float rs = 1.f;
                if (RS) { const f32x4 a = *(const f32x4*)(ssq + (size_t)row * 32 + fq * 8), b = *(const f32x4*)(ssq + (size_t)row * 32 + fq * 8 + 4);
                    float s = ((a.x + a.y) + (a.z + a.w)) + ((b.x + b.y) + (b.z + b.w)); s += __shfl_xor(s, 16); s += __shfl_xor(s, 32);
                    rs = 1.0f / sqrtf(s * (1.0f / 2048.f) + 1e-6f); }
#pragma unroll
                for (int bj = 0; bj < 2; ++bj) { f32x4 v0 = acc[ai][bj][m][0], v1 = acc[ai][bj][m][1];
                    if (RS) { v0 = v0 * rs; v1 = v1 * rs; }
                    if (ACT == 2) {
#pragma unroll
                        for (int e = 0; e < 4; ++e) { float a = fmaxf(v0[e], 0.f), b = fmaxf(v1[e], 0.f); v0[e] = a * a; v1[e] = b * b; } }
                    u32x4 w; w.x = cvt_pk_bf16(v0[0], v0[1]); w.y = cvt_pk_bf16(v0[2], v0[3]); w.z = cvt_pk_bf16(v1[0], v1[1]); w.w = cvt_pk_bf16(v1[2], v1[3]);
                    *(u32x4*)(rowp + bj * HALF) = w; } }
    }
};
template <bool OUT_F32> struct EpiRes {
    static constexpr bool PERM = true, AFTER_DRAIN = false;
    bf16_t* h; float* outf; int ldc; float* ssq; const float* ssq_in;
    __device__ __forceinline__ void operator()(const f32x4 (&acc)[2][2][4][2], const Unit& u, int wr, int wc, int fr, int fq) const {
        const int col0 = u.pn * BM + wc * 32 + 8 * fq;
#pragma unroll
        for (int ai = 0; ai < 2; ++ai) {
            float rs2[4];
#pragma unroll
            for (int m = 0; m < 4; ++m) { rs2[m] = 1.f;
                if (ssq_in) { const int row = u.pm * BM + ai * HALF + wr * 64 + m * 16 + fr;
                    const f32x4 a = *(const f32x4*)(ssq_in + (size_t)row * 32 + fq * 8), b = *(const f32x4*)(ssq_in + (size_t)row * 32 + fq * 8 + 4);
                    float s = ((a.x + a.y) + (a.z + a.w)) + ((b.x + b.y) + (b.z + b.w)); s += __shfl_xor(s, 16); s += __shfl_xor(s, 32);
                    rs2[m] = 1.0f / (s * (1.0f / 2048.f) + 1e-6f); } }
            asm volatile("" : "+v"(rs2[0]), "+v"(rs2[1]), "+v"(rs2[2]), "+v"(rs2[3]) :: "memory");
            u32x4 pre[4][2];
#pragma unroll
            for (int m = 0; m < 4; ++m) { const size_t off = (size_t)(u.pm * BM + ai * HALF + wr * 64 + m * 16 + fr) * ldc + col0;
#pragma unroll
                for (int bj = 0; bj < 2; ++bj) pre[m][bj] = *(const u32x4*)(h + off + bj * HALF); }
#pragma unroll
            for (int m = 0; m < 4; ++m) { const int row = u.pm * BM + ai * HALF + wr * 64 + m * 16 + fr; const size_t off = (size_t)row * ldc + col0; float s = 0.f;
#pragma unroll
                for (int bj = 0; bj < 2; ++bj) { const u32x4 pw = pre[m][bj];
                    const f32x4 b0 = (f32x4){__builtin_bit_cast(float, pw.x << 16), __builtin_bit_cast(float, pw.x & 0xffff0000u), __builtin_bit_cast(float, pw.y << 16), __builtin_bit_cast(float, pw.y & 0xffff0000u)};
                    const f32x4 b1 = (f32x4){__builtin_bit_cast(float, pw.z << 16), __builtin_bit_cast(float, pw.z & 0xffff0000u), __builtin_bit_cast(float, pw.w << 16), __builtin_bit_cast(float, pw.w & 0xffff0000u)};
                    const f32x4 o0 = b0 + acc[ai][bj][m][0] * rs2[m], o1 = b1 + acc[ai][bj][m][1] * rs2[m];
                    if (OUT_F32) { *(f32x4*)(outf + off + bj * HALF) = o0; *(f32x4*)(outf + off + bj * HALF + 4) = o1; }
                    else { s += ((o0.x * o0.x + o0.y * o0.y) + (o0.z * o0.z + o0.w * o0.w)) + ((o1.x * o1.x + o1.y * o1.y) + (o1.z * o1.z + o1.w * o1.w));
                        u32x4 w; w.x = cvt_pk_bf16(o0.x, o0.y); w.y = cvt_pk_bf16(o0.z, o0.w); w.z = cvt_pk_bf16(o1.x, o1.y); w.w = cvt_pk_bf16(o1.z, o1.w); *(u32x4*)(h + off + bj * HALF) = w; } }
                if (!OUT_F32) { s += __shfl_xor(s, 16); s += __shfl_xor(s, 32);
                    if (fq == 0) ssq[(size_t)row * 32 + u.pn * 4 + wc] = s; } }
            asm volatile("" ::: "memory");
        }
    }
};

template <class Epi, class Sched, bool ALIGN_EPI = false, bool SP2 = false>
__device__ __forceinline__ void gemm_phase(PG8_LAS unsigned char* lds, const Gemm g, const Sched& S, const Epi& E) {
    int tid_l = threadIdx.x; asm volatile("" : "+v"(tid_l));
    const int tid = tid_l, wid = __builtin_amdgcn_readfirstlane(tid >> 6), lane = tid & 63, wr = wid >> 2, wc = wid & 3, fr = lane & 15, fq = lane >> 4;
    const int K = g.K, nt = K / BK;
    unsigned voffA[2], voffB[2];
#pragma unroll
    for (int i = 0; i < 2; ++i) { int R, C; stage_rc(tid * 16 + i * 8192, R, C); const int Rb = Epi::PERM ? ((R & ~31) + perm32(R & 31)) : R;
        voffA[i] = (unsigned)(R * K + C) * 2u; voffB[i] = (unsigned)(Rb * K + C) * 2u; }
    const size_t kstep = (size_t)(BK * 2);
    const size_t hstep = (size_t)HALF * K * 2;
    const size_t tstep = 2 * hstep;
    const unsigned ldsw = (unsigned)wid * 1024u;
    const int aoff = lds_byte(wr * 64 + fr, fq * 8), boff = lds_byte(wc * 32 + fr, fq * 8);
#define PG8_SA(b, h) (((b) * 2 + (h)) * HTB)
#define PG8_SB(b, h) ((4 + (b) * 2 + (h)) * HTB)
#define PG8_STAGE(bufoff, gbase, voff) do { _Pragma("unroll") for (int _i = 0; _i < 2; ++_i) \
        __builtin_amdgcn_global_load_lds((const unsigned*)((const char*)(gbase) + (voff)[_i]), (PG8_LAS unsigned*)(lds + (bufoff) + ldsw + _i * 8192), 16, 0, 0); } while (0)
#define PG8_LDA(dst, b, h) do { _Pragma("unroll") for (int m = 0; m < 4; ++m) _Pragma("unroll") for (int k = 0; k < 2; ++k) dst[m][k] = *(const PG8_LAS bf16x8*)(lds + PG8_SA(b, h) + aoff + m * 2048 + k * 1024); } while (0)
#define PG8_LDB(dst, b, h) do { _Pragma("unroll") for (int n = 0; n < 2; ++n) _Pragma("unroll") for (int k = 0; k < 2; ++k) dst[n][k] = *(const PG8_LAS bf16x8*)(lds + PG8_SB(b, h) + boff + n * 2048 + k * 1024); } while (0)
#define PG8_MMA(ai, bj, At, Bt) do { __builtin_amdgcn_s_setprio(1); _Pragma("unroll") for (int m = 0; m < 4; ++m) _Pragma("unroll") for (int n = 0; n < 2; ++n) _Pragma("unroll") for (int k = 0; k < 2; ++k) \
        acc[ai][bj][m][n] = __builtin_amdgcn_mfma_f32_16x16x32_bf16(Bt[n][k], At[m][k], acc[ai][bj][m][n], 0, 0, 0); __builtin_amdgcn_s_setprio(0); } while (0)
#define PG8_WAIT_V(n) asm volatile("s_waitcnt vmcnt(" #n ")" ::: "memory")
#define PG8_WAIT_L(n) asm volatile("s_waitcnt lgkmcnt(" #n ")" ::: "memory")
#define PG8_BAR __builtin_amdgcn_s_barrier()
#define PG8_SCHED __builtin_amdgcn_sched_barrier(0)
    Unit cur, nxt; int ui = 0;
    if (!S.next(0, cur)) return;
    f32x4 acc[2][2][4][2];
#pragma unroll
    for (int a = 0; a < 2; ++a)
#pragma unroll
        for (int b = 0; b < 2; ++b)
#pragma unroll
            for (int m = 0; m < 4; ++m)
#pragma unroll
                for (int n = 0; n < 2; ++n) acc[a][b][m][n] = (f32x4){0.f, 0.f, 0.f, 0.f};
    bf16x8 At[4][2], B0[2][2], B1[2][2];
    const char* cA = (const char*)g.A + (size_t)cur.pm * tstep; const char* cB = (const char*)g.Bt + (size_t)cur.pn * tstep;
    S.a_ready(cur);
    if constexpr (SP2) {
        PG8_STAGE(PG8_SB(0, 0), cB, voffB); PG8_STAGE(PG8_SB(0, 1), cB + hstep, voffB); PG8_STAGE(PG8_SA(0, 0), cA, voffA); PG8_STAGE(PG8_SA(0, 1), cA + hstep, voffA);
        if (wr == 1) PG8_BAR;
        PG8_WAIT_V(2); PG8_BAR;
        PG8_STAGE(PG8_SB(1, 0), cB + kstep, voffB); PG8_STAGE(PG8_SA(1, 0), cA + kstep, voffA); PG8_STAGE(PG8_SB(1, 1), cB + hstep + kstep, voffB);
        PG8_WAIT_V(6); PG8_BAR;
    } else {
        PG8_STAGE(PG8_SB(0, 0), cB, voffB); PG8_STAGE(PG8_SA(0, 0), cA, voffA); PG8_STAGE(PG8_SB(0, 1), cB + hstep, voffB); PG8_STAGE(PG8_SA(0, 1), cA + hstep, voffA);
        if (wr == 1) PG8_BAR;
        PG8_WAIT_V(4); PG8_BAR;
        PG8_STAGE(PG8_SB(1, 0), cB + kstep, voffB); PG8_STAGE(PG8_SA(1, 0), cA + kstep, voffA); PG8_STAGE(PG8_SB(1, 1), cB + hstep + kstep, voffB);
        PG8_WAIT_V(6); PG8_BAR;
    }
    for (;;) {
        const bool has_next = S.next(ui + 1, nxt);
        const char* nA = has_next ? (const char*)g.A + (size_t)nxt.pm * tstep : cA; const char* nB = has_next ? (const char*)g.Bt + (size_t)nxt.pn * tstep : cB;
        for (int t = 0; t < nt; t += 2) {
            const bool last = (t == nt - 2);
            const char* a1 = cA + (size_t)(t + 1) * kstep;
            const char* a2 = last ? nA : cA + (size_t)(t + 2) * kstep; const char* b2 = last ? nB : cB + (size_t)(t + 2) * kstep;
            const char* a3 = a2 + kstep; const char* b3 = b2 + kstep;
            if (last && has_next) S.a_ready(nxt);
            if constexpr (SP2) {
            PG8_LDB(B0, 0, 0); PG8_LDB(B1, 0, 1); PG8_SCHED; PG8_LDA(At, 0, 0); PG8_STAGE(PG8_SA(1, 1), a1 + hstep, voffA);
            PG8_WAIT_V(8); PG8_WAIT_L(0); PG8_BAR; PG8_MMA(0, 0, At, B0); PG8_MMA(0, 1, At, B1); PG8_BAR; PG8_SCHED;
            PG8_LDA(At, 0, 1); PG8_STAGE(PG8_SB(0, 0), b2, voffB); PG8_STAGE(PG8_SB(0, 1), b2 + hstep, voffB); PG8_STAGE(PG8_SA(0, 0), a2, voffA);
            PG8_WAIT_V(8); PG8_WAIT_L(0); PG8_BAR; PG8_MMA(1, 0, At, B0); PG8_MMA(1, 1, At, B1); PG8_BAR; PG8_SCHED;
            PG8_LDB(B0, 1, 0); PG8_LDB(B1, 1, 1); PG8_SCHED; PG8_LDA(At, 1, 0); PG8_STAGE(PG8_SA(0, 1), a2 + hstep, voffA);
            PG8_WAIT_V(8); PG8_WAIT_L(0); PG8_BAR; PG8_MMA(0, 0, At, B0); PG8_MMA(0, 1, At, B1); PG8_BAR; PG8_SCHED;
            PG8_LDA(At, 1, 1); PG8_STAGE(PG8_SB(1, 0), b3, voffB); PG8_STAGE(PG8_SB(1, 1), b3 + hstep, voffB); PG8_STAGE(PG8_SA(1, 0), a3, voffA);
            PG8_WAIT_V(8); PG8_WAIT_L(0); PG8_BAR; PG8_MMA(1, 0, At, B0); PG8_MMA(1, 1, At, B1); PG8_BAR; PG8_SCHED;
            } else {
            PG8_LDB(B0, 0, 0); PG8_SCHED; PG8_LDA(At, 0, 0); PG8_STAGE(PG8_SA(1, 1), a1 + hstep, voffA);
            PG8_WAIT_L(8); PG8_BAR; PG8_WAIT_L(0); PG8_MMA(0, 0, At, B0); PG8_BAR; PG8_SCHED;
            PG8_LDB(B1, 0, 1); PG8_STAGE(PG8_SB(0, 0), b2, voffB);
            PG8_BAR; PG8_WAIT_L(0); PG8_MMA(0, 1, At, B1); PG8_BAR;
            PG8_LDA(At, 0, 1); PG8_STAGE(PG8_SA(0, 0), a2, voffA);
            PG8_BAR; PG8_WAIT_L(0); PG8_MMA(1, 0, At, B0); PG8_BAR; PG8_SCHED;
            PG8_STAGE(PG8_SB(0, 1), b2 + hstep, voffB);
            PG8_WAIT_V(6); PG8_BAR; PG8_MMA(1, 1, At, B1); PG8_BAR;
            PG8_LDB(B0, 1, 0); PG8_SCHED; PG8_LDA(At, 1, 0); PG8_STAGE(PG8_SA(0, 1), a2 + hstep, voffA);
            PG8_WAIT_L(8); PG8_BAR; PG8_WAIT_L(0); PG8_MMA(0, 0, At, B0); PG8_BAR; PG8_SCHED;
            PG8_LDB(B1, 1, 1); PG8_STAGE(PG8_SB(1, 0), b3, voffB);
            PG8_BAR; PG8_WAIT_L(0); PG8_MMA(0, 1, At, B1); PG8_BAR;
            PG8_LDA(At, 1, 1); PG8_STAGE(PG8_SA(1, 0), a3, voffA);
            PG8_BAR; PG8_WAIT_L(0); PG8_MMA(1, 0, At, B0); PG8_BAR; PG8_SCHED;
            PG8_STAGE(PG8_SB(1, 1), b3 + hstep, voffB);
            PG8_WAIT_V(6); PG8_BAR; PG8_MMA(1, 1, At, B1); PG8_BAR;
            }
        }
        if constexpr (ALIGN_EPI) { if (wr == 0) PG8_BAR; }
        if constexpr (!Epi::AFTER_DRAIN) { E(acc, cur, wr, wc, fr, fq); S.done(cur); }
        if (!has_next) break;
#pragma unroll
        for (int a = 0; a < 2; ++a)
#pragma unroll
            for (int b = 0; b < 2; ++b)
#pragma unroll
                for (int m = 0; m < 4; ++m)
#pragma unroll
                    for (int n = 0; n < 2; ++n) acc[a][b][m][n] = (f32x4){0.f, 0.f, 0.f, 0.f};
        cur = nxt; cA = nA; cB = nB; ++ui;
        if constexpr (ALIGN_EPI) { if (wr == 1) PG8_BAR; }
    }
    PG8_WAIT_V(0);
    if constexpr (!ALIGN_EPI) { if (wr == 0) PG8_BAR; }
    PG8_BAR;
#undef PG8_SA
#undef PG8_SB
#undef PG8_STAGE
#undef PG8_LDA
#undef PG8_LDB
#undef PG8_MMA
#undef PG8_WAIT_V
#undef PG8_WAIT_L
#undef PG8_BAR
#undef PG8_SCHED
}
}

#define LAS __attribute__((address_space(3)))
typedef unsigned short bf16;
typedef unsigned v4u __attribute__((ext_vector_type(4)));
typedef unsigned v2u __attribute__((ext_vector_type(2)));
typedef float f32x4 __attribute__((ext_vector_type(4)));
typedef float f32x16 __attribute__((ext_vector_type(16)));
typedef short bf16x8 __attribute__((ext_vector_type(8)));

constexpr int SEQ = 8192, DM = 2048, FF = 8192, NPROJ = 6144, GIN = 6160, NWAVES = 8, NTHR = 512;
constexpr float EPS = 1e-6f, LOG2E = 1.4426950408889634f;
constexpr size_t MiB = 1u << 20;
constexpr size_t WS_W1T = 16 * MiB, WS_W2T = 144 * MiB, WS_WINT = 272 * MiB, WS_WOAT = 320 * MiB, WS_WKVT = 336 * MiB, WS_WQT = 340 * MiB, WS_WOBT = 356 * MiB;
constexpr size_t WS_XN = 372 * MiB, WS_UN = 404 * MiB, WS_HB = 436 * MiB, WS_PROJ = 436 * MiB, WS_QB = 436 * MiB, WS_OB = 468 * MiB, WS_KVB = 564 * MiB, WS_Y = 580 * MiB;
constexpr size_t WS_GLR = 612 * MiB, WS_QT = 614 * MiB, WS_KTT = 630 * MiB, WS_VT = 646 * MiB, WS_G = 678 * MiB, WS_AG = 680 * MiB, WS_SLOC = 684 * MiB, WS_SINIT = 716 * MiB, WS_OG = 748 * MiB, WS_END = 813 * MiB;
constexpr int LDS_BYTES = 147456;

__device__ __forceinline__ unsigned f2bf(float f) { unsigned u = __builtin_bit_cast(unsigned, f); return (u + 0x7fffu + ((u >> 16) & 1u)) >> 16; }
typedef float f32x2_t __attribute__((ext_vector_type(2))); typedef __bf16 bf16x2_t __attribute__((ext_vector_type(2)));
__device__ __forceinline__ unsigned pk2(float lo, float hi) { f32x2_t v = {lo, hi}; bf16x2_t b = __builtin_convertvector(v, bf16x2_t); return __builtin_bit_cast(unsigned, b); }
__device__ __forceinline__ float bflo(unsigned w) { return __builtin_bit_cast(float, w << 16); }
__device__ __forceinline__ float bfhi(unsigned w) { return __builtin_bit_cast(float, w & 0xffff0000u); }
__device__ __forceinline__ float bf2f(bf16 b) { return __builtin_bit_cast(float, ((unsigned)b) << 16); }
__device__ __forceinline__ float wave_sum(float v) {
#pragma unroll
    for (int o = 1; o < 64; o <<= 1) v += __shfl_xor(v, o);
    return v;
}
__device__ __forceinline__ int crow(int r, int hi) { return (r & 3) + 8 * (r >> 2) + 4 * hi; }
__device__ __forceinline__ int swap23(int x) { return (x & ~12) | ((x & 4) << 1) | ((x & 8) >> 1); }
#define LDS_WAIT() asm volatile("s_waitcnt lgkmcnt(0)" ::: "memory")
#define MFMA32(a, b, c) __builtin_amdgcn_mfma_f32_32x32x16_bf16((a), (b), (c), 0, 0, 0)
__device__ __forceinline__ bf16x8 pack8(float a0, float a1, float a2, float a3, float a4, float a5, float a6, float a7) {
    v4u w; w.x = pg8::cvt_pk_bf16(a0, a1); w.y = pg8::cvt_pk_bf16(a2, a3); w.z = pg8::cvt_pk_bf16(a4, a5); w.w = pg8::cvt_pk_bf16(a6, a7); return __builtin_bit_cast(bf16x8, w);
}

struct Params { const float* in[18]; float* out; unsigned char* ws; };

#define XB_TMO      128
#define XB_XCNT(j)  (256  + 64 * (j))
#define XB_XSUB(j)  (1280 + 64 * (j))
#define XB_XGEN(j)  (2304 + 64 * (j))
#define XB_TOP      3328
#define XB_TOPGEN   3392
#define XCD_BAR_WORDS 3456
#define XB_SPIN_CAP (1u << 18)
__device__ __forceinline__ unsigned xb_ld(unsigned* p)              { return __hip_atomic_load(p, __ATOMIC_RELAXED, __HIP_MEMORY_SCOPE_AGENT); }
__device__ __forceinline__ unsigned xb_add(unsigned* p, unsigned v) { return __hip_atomic_fetch_add(p, v, __ATOMIC_RELAXED, __HIP_MEMORY_SCOPE_AGENT); }
__device__ __forceinline__ unsigned xb_xcc_id() { return (unsigned)__builtin_amdgcn_s_getreg((3 << 11) | 20) & 0xFu; }
#define XB_SPIN(cond, bar) do { unsigned _sp = 0; while (cond) { __builtin_amdgcn_s_sleep(1); \
    if ((++_sp & 255u) == 0u) { if (xb_ld(&(bar)[XB_TMO])) break; if (_sp > XB_SPIN_CAP) { atomicAdd(&(bar)[XB_TMO], 1u); break; } } } } while (0)
struct XcdBarrier { unsigned* bar; unsigned x; volatile LAS unsigned* st; };
__device__ __forceinline__ XcdBarrier xcd_barrier_post(unsigned* bar, volatile LAS unsigned* st) {
    XcdBarrier b; b.bar = bar; b.x = xb_xcc_id(); b.st = st;
    if (threadIdx.x == 0) (void)xb_add(&bar[XB_XCNT(b.x)], 1u);
    return b;
}
__device__ __forceinline__ void xcd_barrier_complete(unsigned* bar, unsigned x, unsigned& nloc, unsigned& nx) {
    const unsigned G = gridDim.x * gridDim.y * gridDim.z;
    unsigned sum, cnt, mine, sp = 0u;
    for (;;) {
        sum = 0u; cnt = 0u; mine = 0u;
#pragma unroll
        for (unsigned j = 0; j < 16; ++j) { const unsigned c = xb_ld(&bar[XB_XCNT(j)]); sum += c; cnt += (c > 0u) ? 1u : 0u; mine = (j == x) ? c : mine; }
        if (sum == G) break;
        __builtin_amdgcn_s_sleep(1);
        if ((++sp & 255u) == 0u) { if (xb_ld(&bar[XB_TMO])) break; if (sp > XB_SPIN_CAP) { atomicAdd(&bar[XB_TMO], 1u); break; } }
    }
    nloc = mine > 0u ? mine : 1u; nx = cnt > 0u ? cnt : 1u;
}
__device__ __forceinline__ void xcd_barrier(const XcdBarrier& b) {
    asm volatile("s_waitcnt vmcnt(0)" ::: "memory");
    __syncthreads();
    int t0_ = threadIdx.x; asm volatile("" : "+v"(t0_));
    if (t0_ == 0) {
        unsigned* bar = b.bar;
        __builtin_amdgcn_s_waitcnt(0);
        unsigned nloc = b.st[0], nx = b.st[1];
        if (nloc == 0u) { xcd_barrier_complete(bar, b.x, nloc, nx); b.st[0] = nloc; b.st[1] = nx; }
        const unsigned old = xb_add(&bar[XB_XSUB(b.x)], 1u);
        const unsigned gen = old / nloc;
        if (old + 1u == (gen + 1u) * nloc) {
            __builtin_amdgcn_fence(__ATOMIC_RELEASE, "agent");
            asm volatile("s_waitcnt vmcnt(0)" ::: "memory");
            const unsigned og = xb_add(&bar[XB_TOP], 1u);
            const unsigned tg = og / nx;
            if (og + 1u == (tg + 1u) * nx) xb_add(&bar[XB_TOPGEN], 1u);
            else XB_SPIN(xb_ld(&bar[XB_TOPGEN]) == tg, bar);
            __builtin_amdgcn_fence(__ATOMIC_ACQUIRE, "agent");
            xb_add(&bar[XB_XGEN(b.x)], 1u);
            asm volatile("s_waitcnt vmcnt(0)" ::: "memory");
        } else {
            XB_SPIN(xb_ld(&bar[XB_XGEN(b.x)]) == gen, bar);
            __builtin_amdgcn_fence(__ATOMIC_ACQUIRE, "agent");
            asm volatile("s_waitcnt vmcnt(0)" ::: "memory");
        }
    }
    __syncthreads();
}


__device__ __forceinline__ void transpose_item(const float* W, int ldw, int K, int nblk, bf16* WT, int row_off, LAS float* scr, int item, int lane, const float* gain = nullptr) {
    const int kb = item / nblk, nb = item % nblk, k0 = 64 * kb, n0 = 32 * nb;
    float wv[32];
    { const float* wp = W + (size_t)(k0 + (lane >> 5)) * ldw + n0 + (lane & 31);
#pragma unroll
      for (int i = 0; i < 32; ++i) wv[i] = wp[(size_t)(2 * i) * ldw]; }
#pragma unroll
    for (int i = 0; i < 32; ++i) scr[(2 * i + (lane >> 5)) * 33 + (lane & 31)] = wv[i];
    LDS_WAIT(); asm volatile("" ::: "memory");
    const int c = lane & 7;
    f32x4 ga = (f32x4){1.f, 1.f, 1.f, 1.f}, gb = ga;
    if (gain) { ga = *(const f32x4*)(gain + k0 + 8 * c); gb = *(const f32x4*)(gain + k0 + 8 * c + 4); }
#pragma unroll
    for (int j = 0; j < 4; ++j) { const int n = (lane >> 3) + 8 * j; const LAS float* s = scr + (8 * c) * 33 + n;
        v4u o; o.x = pk2(s[0 * 33] * ga.x, s[1 * 33] * ga.y); o.y = pk2(s[2 * 33] * ga.z, s[3 * 33] * ga.w); o.z = pk2(s[4 * 33] * gb.x, s[5 * 33] * gb.y); o.w = pk2(s[6 * 33] * gb.z, s[7 * 33] * gb.w);
        *(v4u*)(WT + (size_t)(row_off + n0 + n) * K + k0 + 8 * c) = o; }
    LDS_WAIT(); asm volatile("" ::: "memory");
}

__device__ __forceinline__ void convert_phase(const Params& p, LAS unsigned char* lds, int gw, int NGW, int wave, int lane) {
    LAS float* scr = (LAS float*)(lds + wave * 16384);
    unsigned char* ws = p.ws;
    constexpr int NITEMS = 32768 + 32768 + 12288 + 4096 + 256 + 256 + 4096 + 4096;
    for (int it = gw; it < NITEMS; it += NGW) {
        int r = it;
        if (r < 32768) { const int l = r >> 13; transpose_item(p.in[3] + (size_t)l * DM * FF, FF, DM, FF / 32, (bf16*)(ws + WS_W1T) + (size_t)l * FF * DM, 0, scr, r & 8191, lane, p.in[2] + l * DM); continue; } r -= 32768;
        if (r < 32768) { const int l = r >> 13; transpose_item(p.in[4] + (size_t)l * FF * DM, DM, FF, DM / 32, (bf16*)(ws + WS_W2T) + (size_t)l * DM * FF, 0, scr, r & 8191, lane); continue; } r -= 32768;
        if (r < 12288) { const int l = r / 6144; transpose_item(p.in[5] + (size_t)l * DM * GIN, GIN, DM, NPROJ / 32, (bf16*)(ws + WS_WINT) + (size_t)l * NPROJ * DM, 0, scr, r % 6144, lane); continue; } r -= 12288;
        if (r < 4096) { const int l = r >> 11; transpose_item(p.in[9] + (size_t)l * DM * DM, DM, DM, DM / 32, (bf16*)(ws + WS_WOAT) + (size_t)l * DM * DM, 0, scr, r & 2047, lane); continue; } r -= 4096;
        if (r < 256) { transpose_item(p.in[11], 256, DM, 8, (bf16*)(ws + WS_WKVT), 0, scr, r, lane, p.in[10]); continue; } r -= 256;
        if (r < 256) { transpose_item(p.in[12], 256, DM, 8, (bf16*)(ws + WS_WKVT), 256, scr, r, lane, p.in[10]); continue; } r -= 256;
        if (r < 4096) { const int l = r >> 11; transpose_item(p.in[14] + (size_t)l * DM * DM, DM, DM, DM / 32, (bf16*)(ws + WS_WQT) + (size_t)l * DM * DM, 0, scr, r & 2047, lane, p.in[1] + (2 + l) * DM); continue; } r -= 4096;
        { const int l = r >> 11; transpose_item(p.in[17] + (size_t)l * DM * DM, DM, DM, DM / 32, (bf16*)(ws + WS_WOBT) + (size_t)l * DM * DM, 0, scr, r & 2047, lane); }
    }
}

template <bool GLRF, bool KVN, bool IN16>
__device__ __forceinline__ void norm_phase(const float* hin, const bf16* hin16, bf16* hraw, const float* g1, bf16* XN, const float* w_in_l, float* GLRo, const float* g2, bf16* UN,
                                           LAS unsigned char* lds, int gw, int NGW, int tid, int lane) {
    LAS bf16* WgB = (LAS bf16*)lds;
    if (GLRF) {
        for (int k = tid; k < DM; k += NTHR) { const f32x4* src = (const f32x4*)(w_in_l + (size_t)k * GIN + NPROJ);
            const f32x4 a = src[0], b = src[1], c = src[2], d = src[3];
            WgB[0 * 2056 + k] = (bf16)f2bf(a.x); WgB[1 * 2056 + k] = (bf16)f2bf(a.y); WgB[2 * 2056 + k] = (bf16)f2bf(a.z); WgB[3 * 2056 + k] = (bf16)f2bf(a.w);
            WgB[4 * 2056 + k] = (bf16)f2bf(b.x); WgB[5 * 2056 + k] = (bf16)f2bf(b.y); WgB[6 * 2056 + k] = (bf16)f2bf(b.z); WgB[7 * 2056 + k] = (bf16)f2bf(b.w);
            WgB[8 * 2056 + k] = (bf16)f2bf(c.x); WgB[9 * 2056 + k] = (bf16)f2bf(c.y); WgB[10 * 2056 + k] = (bf16)f2bf(c.z); WgB[11 * 2056 + k] = (bf16)f2bf(c.w);
            WgB[12 * 2056 + k] = (bf16)f2bf(d.x); WgB[13 * 2056 + k] = (bf16)f2bf(d.y); WgB[14 * 2056 + k] = (bf16)f2bf(d.z); WgB[15 * 2056 + k] = (bf16)f2bf(d.w); }
    }
    for (int row = gw; row < SEQ; row += NGW) {
        f32x4 v[8]; float ss = 0.f;
        if (IN16) { const v2u* xr = (const v2u*)(hin16 + (size_t)row * DM) + lane;
#pragma unroll
            for (int j = 0; j < 8; ++j) { const v2u w = xr[64 * j]; v[j] = (f32x4){bflo(w.x), bfhi(w.x), bflo(w.y), bfhi(w.y)}; }
        } else { const f32x4* xr = (const f32x4*)(hin + (size_t)row * DM) + lane;
#pragma unroll
            for (int j = 0; j < 8; ++j) v[j] = xr[64 * j];
            if (hraw) { v2u* o8 = (v2u*)(hraw + (size_t)row * DM) + lane;
#pragma unroll
                for (int j = 0; j < 8; ++j) { v2u w; w.x = pk2(v[j].x, v[j].y); w.y = pk2(v[j].z, v[j].w); o8[64 * j] = w; } } }
#pragma unroll
        for (int j = 0; j < 8; ++j) ss += (v[j].x * v[j].x + v[j].y * v[j].y) + (v[j].z * v[j].z + v[j].w * v[j].w);
        const float rstd = __builtin_amdgcn_rsqf(wave_sum(ss) * (1.0f / DM) + EPS);
        if (KVN) {
            v2u* o8 = (v2u*)(UN + (size_t)row * DM) + lane;
#pragma unroll
            for (int j = 0; j < 8; ++j) { const f32x4 gg = ((const f32x4*)g2)[lane + 64 * j]; const f32x4 y = v[j] * rstd * gg; v2u w; w.x = pk2(y.x, y.y); w.y = pk2(y.z, y.w); o8[64 * j] = w; }
        }
        v2u* o8 = (v2u*)(XN + (size_t)row * DM) + lane;
#pragma unroll
        for (int j = 0; j < 8; ++j) { const f32x4 gg = ((const f32x4*)g1)[lane + 64 * j]; v[j] = v[j] * rstd * gg; v2u w; w.x = pk2(v[j].x, v[j].y); w.y = pk2(v[j].z, v[j].w); o8[64 * j] = w; }
    }
    if (GLRF) {
        __syncthreads();
        const int wave = __builtin_amdgcn_readfirstlane(tid >> 6), r32 = lane & 31, hi = lane >> 5;
        LAS float* P = (LAS float*)(lds + 65792);
        for (int i0 = 0; (long)i0 * NGW < SEQ; i0 += 4) {
            const int rowm = (gw - wave + (r32 >> 2)) + NGW * (i0 + (r32 & 3));
            const bf16* ap = XN + (size_t)(rowm < SEQ ? rowm : 0) * DM + 256 * wave + 8 * hi;
            const LAS bf16* bp = WgB + (r32 & 15) * 2056 + 256 * wave + 8 * hi;
            f32x16 acc;
#pragma unroll
            for (int r = 0; r < 16; ++r) acc[r] = 0.f;
#pragma unroll
            for (int ks = 0; ks < 16; ++ks) { const bf16x8 a = *(const bf16x8*)(ap + 16 * ks); const bf16x8 b = *(const LAS bf16x8*)(bp + 16 * ks); acc = MFMA32(a, b, acc); }
#pragma unroll
            for (int r = 0; r < 16; ++r) P[wave * 1024 + r * 64 + lane] = acc[r];
            __syncthreads();
            { const int m = tid >> 4, n = tid & 15, r = (m & 3) + 4 * (m >> 3), l2 = n + 32 * ((m >> 2) & 1); float s = 0.f;
#pragma unroll
              for (int w = 0; w < 8; ++w) s += P[w * 1024 + r * 64 + l2];
              const int rowo = (gw - wave + (m >> 2)) + NGW * (i0 + (m & 3));
              if (rowo < SEQ) GLRo[(size_t)rowo * 16 + n] = s; }
            __syncthreads();
        }
    }
}

__device__ __forceinline__ void gla_prep_unit(const Params& p, int li, int c, int h, LAS unsigned char* lds, int tid, int wave, int lane) {
    unsigned char* ws = p.ws;
    const bf16* PROJ = (const bf16*)(ws + WS_PROJ);
    const float* GLR = (const float*)(ws + WS_GLR);
    bf16* QT = (bf16*)(ws + WS_QT); bf16* KTT = (bf16*)(ws + WS_KTT); bf16* VT = (bf16*)(ws + WS_VT); bf16* AG = (bf16*)(ws + WS_AG);
    float* G = (float*)(ws + WS_G);
    LAS float* Bl = (LAS float*)lds; LAS bf16* Ql = (LAS bf16*)(lds + 65536); LAS bf16* Kl = (LAS bf16*)(lds + 99328); LAS float* T = (LAS float*)(lds + 133120);
    const int ch = c * 4 + h;
    {
        LAS bf16* Vl = (LAS bf16*)lds;
        if (tid < 256) *((LAS f32x4*)(lds + 135168) + tid) = *((const f32x4*)(GLR + (size_t)c * 64 * 16) + tid);
#pragma unroll
        for (int i = 0; i < 8; ++i) { const int it = tid + 512 * i, r = it >> 6, cg = it & 63;
            *((LAS v4u*)Vl + it) = *(const v4u*)(PROJ + ((size_t)c * 64 + r) * NPROJ + 2048 + h * 512 + 8 * cg); }
        __syncthreads();
#pragma unroll
        for (int i = 0; i < 8; ++i) { const int f = wave + 8 * i;
            const int e = (f >> 2) * 32 + (lane & 31), tok0 = (f & 3) * 16 + 8 * (lane >> 5);
            unsigned short t8[8];
#pragma unroll
            for (int j = 0; j < 8; ++j) t8[j] = Vl[(tok0 + j) * 512 + e];
            v4u o; o.x = t8[0] | ((unsigned)t8[1] << 16); o.y = t8[2] | ((unsigned)t8[3] << 16); o.z = t8[4] | ((unsigned)t8[5] << 16); o.w = t8[6] | ((unsigned)t8[7] << 16);
            *(v4u*)(VT + (size_t)ch * 32768 + (f * 64 + lane) * 8) = o; }
        __syncthreads();
    }
    {
        const int d = tid & 255, hf = wave >> 2, col = h * 256 + d;
        const float* wg2 = p.in[6] + (size_t)li * 16 * 1024; const float bias = p.in[7][li * 1024 + col];
        float w[16];
#pragma unroll
        for (int r = 0; r < 16; ++r) w[r] = wg2[r * 1024 + col];
        float cum = 0.f;
        for (int i = 0; i < 32; ++i) {
            const LAS f32x4* gp = (const LAS f32x4*)(lds + 135168) + (hf * 32 + i) * 4;
            const f32x4 g0 = gp[0], g1 = gp[1], g2 = gp[2], g3 = gp[3];
            float z = bias;
            z += g0.x * w[0] + g0.y * w[1] + g0.z * w[2] + g0.w * w[3]; z += g1.x * w[4] + g1.y * w[5] + g1.z * w[6] + g1.w * w[7];
            z += g2.x * w[8] + g2.y * w[9] + g2.z * w[10] + g2.w * w[11]; z += g3.x * w[12] + g3.y * w[13] + g3.z * w[14] + g3.w * w[15];
            const float ls = fminf(z, 0.f) - __logf(1.0f + __expf(-fabsf(z)));
            cum += ls * 0.0625f;
            Bl[(hf * 32 + i) * 256 + d] = cum;
        }
        T[hf * 256 + d] = cum;
    }
    __syncthreads();
    if (tid < 256) G[ch * 256 + tid] = __expf(T[tid] + T[256 + tid]);
#pragma unroll
    for (int i = 0; i < 4; ++i) {
        const int it = tid + 512 * i, r = it >> 5, dg = it & 31; const size_t row = (size_t)c * 64 + r;
        const v4u q8 = *(const v4u*)(PROJ + row * NPROJ + h * 256 + 8 * dg), k8 = *(const v4u*)(PROJ + row * NPROJ + 1024 + h * 256 + 8 * dg);
        f32x4 b0 = *(const LAS f32x4*)(Bl + r * 256 + 8 * dg), b1 = *(const LAS f32x4*)(Bl + r * 256 + 8 * dg + 4);
        const f32x4 t0a = *(const LAS f32x4*)(T + 8 * dg), t0b = *(const LAS f32x4*)(T + 8 * dg + 4), t1a = *(const LAS f32x4*)(T + 256 + 8 * dg), t1b = *(const LAS f32x4*)(T + 256 + 8 * dg + 4);
        if (r >= 32) { b0 = b0 + t0a; b1 = b1 + t0b; }
        const f32x4 bl0 = t0a + t1a, bl1 = t0b + t1b;
        float Bv[8] = {b0.x, b0.y, b0.z, b0.w, b1.x, b1.y, b1.z, b1.w}, BL[8] = {bl0.x, bl0.y, bl0.z, bl0.w, bl1.x, bl1.y, bl1.z, bl1.w};
        float qv[8] = {bflo(q8.x), bfhi(q8.x), bflo(q8.y), bfhi(q8.y), bflo(q8.z), bfhi(q8.z), bflo(q8.w), bfhi(q8.w)};
        float kv[8] = {bflo(k8.x), bfhi(k8.x), bflo(k8.y), bfhi(k8.y), bflo(k8.z), bfhi(k8.z), bflo(k8.w), bfhi(k8.w)};
        float qt[8], kh[8], kt[8];
#pragma unroll
        for (int j = 0; j < 8; ++j) { qt[j] = qv[j] * 0.0625f * __expf(Bv[j]); kh[j] = kv[j] * __expf(-Bv[j]); kt[j] = kv[j] * __expf(BL[j] - Bv[j]); }
        const int pbase = 16 * (dg >> 1) + 4 * (dg & 1);
        v2u w;
        w.x = pk2(qt[0], qt[1]); w.y = pk2(qt[2], qt[3]); *(LAS v2u*)(Ql + r * 264 + pbase) = w;
        w.x = pk2(qt[4], qt[5]); w.y = pk2(qt[6], qt[7]); *(LAS v2u*)(Ql + r * 264 + pbase + 8) = w;
        w.x = pk2(kh[0], kh[1]); w.y = pk2(kh[2], kh[3]); *(LAS v2u*)(Kl + r * 264 + pbase) = w;
        w.x = pk2(kh[4], kh[5]); w.y = pk2(kh[6], kh[7]); *(LAS v2u*)(Kl + r * 264 + pbase + 8) = w;
        v4u o; o.x = pk2(kt[0], kt[1]); o.y = pk2(kt[2], kt[3]); o.z = pk2(kt[4], kt[5]); o.w = pk2(kt[6], kt[7]);
        *(LAS v4u*)(Bl + r * 256 + 8 * dg) = o;
    }
    __syncthreads();
#pragma unroll
    for (int i = 0; i < 4; ++i) { const int f = wave + 8 * i, ib = f >> 4, kd = f & 15;
        const v4u v = *(const LAS v4u*)(Ql + (32 * ib + (lane & 31)) * 264 + 16 * kd + 8 * (lane >> 5));
        *(v4u*)(QT + (size_t)ch * 16384 + (f * 64 + lane) * 8) = v; }
    { const LAS bf16* Ktl = (const LAS bf16*)lds;
#pragma unroll
      for (int i = 0; i < 4; ++i) { const int f = wave + 8 * i;
        const int d = (f >> 2) * 32 + (lane & 31), tok0 = (f & 3) * 16 + 8 * (lane >> 5);
        unsigned short t8[8];
#pragma unroll
        for (int j = 0; j < 8; ++j) t8[j] = Ktl[(tok0 + j) * 512 + 16 * (d >> 3) + (d & 7)];
        v4u o; o.x = t8[0] | ((unsigned)t8[1] << 16); o.y = t8[2] | ((unsigned)t8[3] << 16); o.z = t8[4] | ((unsigned)t8[5] << 16); o.w = t8[6] | ((unsigned)t8[7] << 16);
        *(v4u*)(KTT + (size_t)ch * 16384 + (f * 64 + lane) * 8) = o; } }
    if (wave < 4) {
        const int ib = wave >> 1, jb = wave & 1, r32 = lane & 31, hi = lane >> 5;
        f32x16 acc;
#pragma unroll
        for (int r = 0; r < 16; ++r) acc[r] = 0.f;
        if (jb <= ib) {
#pragma unroll
            for (int ks = 0; ks < 16; ++ks) {
                const bf16x8 a = *(const LAS bf16x8*)(Ql + (32 * ib + r32) * 264 + 16 * ks + 8 * hi);
                const bf16x8 b = *(const LAS bf16x8*)(Kl + (32 * jb + r32) * 264 + 16 * ks + 8 * hi);
                acc = MFMA32(a, b, acc);
            }
        }
#pragma unroll
        for (int r = 0; r < 16; ++r) { const int i = 32 * ib + crow(r, hi), j = 32 * jb + r32;
            AG[((size_t)ch * 64 + i) * 64 + j] = (bf16)f2bf(j <= i ? acc[r] : 0.f); }
    }
    __syncthreads();
}

#define LBAR() asm volatile("s_waitcnt lgkmcnt(0)\n\ts_barrier" ::: "memory")
__device__ __forceinline__ void gla_state_update_lds(f32x16 (&St)[4], const LAS float* GBl, const LAS bf16* KBl, const bf16x8 (&vfr)[4], int dh, int lane, int hi) {
#pragma unroll
    for (int dt = 0; dt < 4; ++dt)
#pragma unroll
        for (int rg = 0; rg < 4; ++rg) { const f32x4 gv = *(const LAS f32x4*)(GBl + 128 * dh + 32 * dt + 8 * rg + 4 * hi);
            St[dt][4 * rg + 0] *= gv.x; St[dt][4 * rg + 1] *= gv.y; St[dt][4 * rg + 2] *= gv.z; St[dt][4 * rg + 3] *= gv.w; }
#pragma unroll
    for (int ks = 0; ks < 4; ++ks)
#pragma unroll
        for (int dt = 0; dt < 4; ++dt) { const bf16x8 afr = *(const LAS bf16x8*)(KBl + ((((4 * dh + dt) * 4 + ks) * 64) + lane) * 8); St[dt] = MFMA32(afr, vfr[ks], St[dt]); }
}

__device__ __forceinline__ void gla_s1_unit(const Params& p, int s, int h, int sl, LAS unsigned char* lds, int tid, int wave, int lane) {
    unsigned char* ws = p.ws;
    const bf16* KTT = (const bf16*)(ws + WS_KTT); const bf16* VT = (const bf16*)(ws + WS_VT); const float* G = (const float*)(ws + WS_G);
    float* SLOC = (float*)(ws + WS_SLOC);
    const int dh = wave >> 2, eb = wave & 3, r32 = lane & 31, hi = lane >> 5, e0 = 128 * sl + 32 * eb;
    f32x16 St[4];
#pragma unroll
    for (int dt = 0; dt < 4; ++dt)
#pragma unroll
        for (int r = 0; r < 16; ++r) St[dt][r] = 0.f;
    v4u pk[4]; float pg = 0.f, gprod = 1.f;
    { const int ch = (s * 8) * 4 + h; const v4u* kp = (const v4u*)(KTT + (size_t)ch * 16384) + tid;
#pragma unroll
      for (int i = 0; i < 4; ++i) pk[i] = kp[512 * i];
      if (tid < 256) pg = G[(size_t)ch * 256 + tid]; }
    bf16x8 vnx[4];
#pragma unroll
    for (int ks = 0; ks < 4; ++ks) vnx[ks] = *(const bf16x8*)(VT + (size_t)((s * 8) * 4 + h) * 32768 + (((e0 >> 5) * 4 + ks) * 64 + lane) * 8);
#pragma unroll 1
    for (int cc = 0; cc < 8; ++cc) {
        const int ch = (s * 8 + cc) * 4 + h, cur = cc & 1;
        LAS bf16* KBl = (LAS bf16*)(lds + cur * 32768); LAS float* GBl = (LAS float*)(lds + 65536 + cur * 1024);
        gprod *= (tid < 256) ? pg : 1.f;
        bf16x8 vfr[4];
#pragma unroll
        for (int ks = 0; ks < 4; ++ks) vfr[ks] = vnx[ks];
        if (cc < 7) {
#pragma unroll
            for (int ks = 0; ks < 4; ++ks) vnx[ks] = *(const bf16x8*)(VT + (size_t)(ch + 4) * 32768 + (((e0 >> 5) * 4 + ks) * 64 + lane) * 8); }
#pragma unroll
        for (int i = 0; i < 4; ++i) *((LAS v4u*)KBl + tid + 512 * i) = pk[i];
        if (tid < 256) GBl[tid] = pg;
        LBAR();
        if (cc < 7) { const int chn = ch + 4; const v4u* kp = (const v4u*)(KTT + (size_t)chn * 16384) + tid;
#pragma unroll
            for (int i = 0; i < 4; ++i) pk[i] = kp[512 * i];
            if (tid < 256) pg = G[(size_t)chn * 256 + tid]; }
        gla_state_update_lds(St, GBl, KBl, vfr, dh, lane, hi);
    }
#pragma unroll
    for (int dt = 0; dt < 4; ++dt)
#pragma unroll
        for (int r = 0; r < 16; ++r) SLOC[((size_t)(s * 4 + h) * 256 + 128 * dh + 32 * dt + crow(r, hi)) * 512 + e0 + r32] = St[dt][r];
    if (sl == 0 && tid < 256) ((float*)(ws + WS_G + MiB))[(s * 4 + h) * 256 + tid] = gprod;
    LBAR();
}

__device__ __forceinline__ void gla_s2_phase(const Params& p, int gtid) {
    unsigned char* ws = p.ws;
    const float* GSEG = (const float*)(ws + WS_G + MiB); const f32x4* SLOC = (const f32x4*)(ws + WS_SLOC); f32x4* SINIT = (f32x4*)(ws + WS_SINIT);
    const int h = gtid >> 15, d = (gtid >> 7) & 255;
    float gs[15]; f32x4 sl[15];
#pragma unroll
    for (int s = 0; s < 15; ++s) { gs[s] = GSEG[(s * 4 + h) * 256 + d]; sl[s] = SLOC[(size_t)s * 131072 + gtid]; }
    f32x4 cur = (f32x4){0.f, 0.f, 0.f, 0.f};
#pragma unroll
    for (int s = 0; s < 16; ++s) {
        SINIT[(size_t)s * 131072 + gtid] = cur;
        if (s < 15) cur = cur * gs[s] + sl[s];
    }
}

__device__ __forceinline__ void gla_s3_unit(const Params& p, int s, int h, int sl, LAS unsigned char* lds, int tid, int wave, int lane) {
    unsigned char* ws = p.ws;
    const bf16* QT = (const bf16*)(ws + WS_QT); const bf16* KTT = (const bf16*)(ws + WS_KTT); const bf16* VT = (const bf16*)(ws + WS_VT); const bf16* AG = (const bf16*)(ws + WS_AG);
    const float* G = (const float*)(ws + WS_G); const float* SINIT = (const float*)(ws + WS_SINIT); bf16* OG = (bf16*)(ws + WS_OG);
    const int dh = wave >> 2, eb = wave & 3, r32 = lane & 31, hi = lane >> 5, e0 = 128 * sl + 32 * eb;
    LAS bf16* KBl = (LAS bf16*)(lds + 65536); LAS float* X = (LAS float*)(lds + 98304); LAS float* GBl = (LAS float*)(lds + 131072);
    v4u pq[4], pk[4]; float pg = 0.f;
    { const int ch = (s * 8) * 4 + h; const v4u* qp = (const v4u*)(QT + (size_t)ch * 16384) + tid; const v4u* kp = (const v4u*)(KTT + (size_t)ch * 16384) + tid;
#pragma unroll
      for (int i = 0; i < 4; ++i) { pq[i] = qp[512 * i]; pk[i] = kp[512 * i]; }
      if (tid < 256) pg = G[(size_t)ch * 256 + tid]; }
    f32x16 St[4];
#pragma unroll
    for (int dt = 0; dt < 4; ++dt)
#pragma unroll
        for (int r = 0; r < 16; ++r) St[dt][r] = SINIT[((size_t)(s * 4 + h) * 256 + 128 * dh + 32 * dt + crow(r, hi)) * 512 + e0 + r32];
#pragma unroll
    for (int i = 0; i < 4; ++i) *((LAS v4u*)lds + tid + 512 * i) = pq[i];
    LBAR();
#pragma unroll 1
    for (int cc = 0; cc < 8; ++cc) {
        const int c = s * 8 + cc, ch = c * 4 + h, cur = cc & 1;
        const LAS bf16* QBl = (const LAS bf16*)(lds + cur * 32768);
        bf16x8 afr[4], vfr[4];
#pragma unroll
        for (int ks = 0; ks < 4; ++ks) {
            afr[ks] = *(const bf16x8*)(AG + ((size_t)ch * 64 + 32 * dh + r32) * 64 + 16 * ks + 8 * hi);
            vfr[ks] = *(const bf16x8*)(VT + (size_t)ch * 32768 + (((e0 >> 5) * 4 + ks) * 64 + lane) * 8); }
        if (cc < 7) { const v4u* qp = (const v4u*)(QT + (size_t)(ch + 4) * 16384) + tid;
#pragma unroll
            for (int i = 0; i < 4; ++i) pq[i] = qp[512 * i]; }
        f32x16 op0, op1;
#pragma unroll
        for (int r = 0; r < 16; ++r) { op0[r] = 0.f; op1[r] = 0.f; }
#pragma unroll
        for (int dt = 0; dt < 4; ++dt)
#pragma unroll
            for (int ss = 0; ss < 2; ++ss) {
                const bf16x8 sb = pack8(St[dt][8 * ss + 0], St[dt][8 * ss + 1], St[dt][8 * ss + 2], St[dt][8 * ss + 3], St[dt][8 * ss + 4], St[dt][8 * ss + 5], St[dt][8 * ss + 6], St[dt][8 * ss + 7]);
                const LAS bf16* qp = QBl + ((8 * dh + 2 * dt + ss) * 64 + lane) * 8;
                const bf16x8 q0 = *(const LAS bf16x8*)qp; const bf16x8 q1 = *(const LAS bf16x8*)(qp + 16 * 512);
                op0 = MFMA32(q0, sb, op0); op1 = MFMA32(q1, sb, op1);
            }
        f32x16 keep, send;
#pragma unroll
        for (int r = 0; r < 16; ++r) { keep[r] = dh ? op1[r] : op0[r]; send[r] = dh ? op0[r] : op1[r]; }
        { LAS float* xd = X + ((1 - dh) * 4 + eb) * 1024 + lane;
#pragma unroll
          for (int r = 0; r < 16; ++r) xd[r * 64] = send[r]; }
#pragma unroll
        for (int i = 0; i < 4; ++i) *((LAS v4u*)KBl + tid + 512 * i) = pk[i];
        if (tid < 256) GBl[tid] = pg;
        LBAR();
        { const LAS float* xs = X + wave * 1024 + lane;
#pragma unroll
          for (int r = 0; r < 16; ++r) keep[r] += xs[r * 64]; }
        if (cc < 7) { const v4u* kp = (const v4u*)(KTT + (size_t)(ch + 4) * 16384) + tid;
#pragma unroll
            for (int i = 0; i < 4; ++i) pk[i] = kp[512 * i];
            if (tid < 256) pg = G[(size_t)(ch + 4) * 256 + tid]; }
#pragma unroll
        for (int ks = 0; ks < 4; ++ks) keep = MFMA32(afr[ks], vfr[ks], keep);
#pragma unroll
        for (int r = 0; r < 16; ++r) OG[((size_t)c * 64 + 32 * dh + crow(r, hi)) * DM + h * 512 + e0 + r32] = (bf16)f2bf(keep[r]);
        gla_state_update_lds(St, GBl, KBl, vfr, dh, lane, hi);
        if (cc < 7) {
#pragma unroll
            for (int i = 0; i < 4; ++i) *((LAS v4u*)(lds + (cur ^ 1) * 32768) + tid + 512 * i) = pq[i]; }
        LBAR();
    }
}

__device__ __forceinline__ void gla_post_phase(const Params& p, int li, int gw, int NGW, int lane) {
    unsigned char* ws = p.ws;
    const bf16* OG = (const bf16*)(ws + WS_OG); const bf16* PROJ = (const bf16*)(ws + WS_PROJ); bf16* Y = (bf16*)(ws + WS_Y);
    const float* go = p.in[8] + li * 512;
    const f32x4 ga = *(const f32x4*)(go + 8 * lane), gb = *(const f32x4*)(go + 8 * lane + 4);
    for (int row = gw; row < SEQ; row += NGW) {
#pragma unroll
        for (int hh = 0; hh < 4; ++hh) {
            const v4u ow = *(const v4u*)(OG + (size_t)row * DM + hh * 512 + 8 * lane);
            const f32x4 a = (f32x4){bflo(ow.x), bfhi(ow.x), bflo(ow.y), bfhi(ow.y)}, b = (f32x4){bflo(ow.z), bfhi(ow.z), bflo(ow.w), bfhi(ow.w)};
            float ss = (a.x * a.x + a.y * a.y) + (a.z * a.z + a.w * a.w) + (b.x * b.x + b.y * b.y) + (b.z * b.z + b.w * b.w);
            const float rstd = 1.0f / sqrtf(wave_sum(ss) * (1.0f / 512.f) + EPS);
            const v4u rr = *(const v4u*)(PROJ + (size_t)row * NPROJ + 4096 + hh * 512 + 8 * lane);
            float rv[8] = {bflo(rr.x), bfhi(rr.x), bflo(rr.y), bfhi(rr.y), bflo(rr.z), bfhi(rr.z), bflo(rr.w), bfhi(rr.w)};
            float yv[8] = {a.x * ga.x, a.y * ga.y, a.z * ga.z, a.w * ga.w, b.x * gb.x, b.y * gb.y, b.z * gb.z, b.w * gb.w};
#pragma unroll
            for (int k = 0; k < 8; ++k) yv[k] = yv[k] * rstd * (rv[k] * __builtin_amdgcn_rcpf(1.0f + __expf(-rv[k])));
            v4u o; o.x = pk2(yv[0], yv[1]); o.y = pk2(yv[2], yv[3]); o.z = pk2(yv[4], yv[5]); o.w = pk2(yv[6], yv[7]);
            *(v4u*)(Y + (size_t)row * DM + hh * 512 + 8 * lane) = o;
        }
    }
}

__device__ __forceinline__ void attn_unit(const Params& p, int lj, int nb, int kh, LAS unsigned char* lds, int tid, int wave, int lane) {
    unsigned char* ws = p.ws;
    const bf16* Q = (const bf16*)(ws + WS_QB); const bf16* KV = (const bf16*)(ws + WS_KVB); bf16* O = (bf16*)(ws + WS_OB);
    const float* gq = p.in[15] + lj * 64; const float* gk = p.in[13]; const float* sinks = p.in[16] + lj * 32;
    LAS bf16* Kl = (LAS bf16*)lds; LAS bf16* VTl = (LAS bf16*)(lds + 36864);
    {
        const int key = tid >> 1, half = tid & 1; const int grow = 128 * (nb - 1) + key;
        v4u kr[4], vr[4];
        if (grow >= 0) {
            const v4u* kp = (const v4u*)(KV + (size_t)grow * 512 + kh * 64 + 32 * half); const v4u* vp = (const v4u*)(KV + (size_t)grow * 512 + 256 + kh * 64 + 32 * half);
#pragma unroll
            for (int i = 0; i < 4; ++i) { kr[i] = kp[i]; vr[i] = vp[i]; }
        } else {
#pragma unroll
            for (int i = 0; i < 4; ++i) { kr[i] = (v4u){0u, 0u, 0u, 0u}; vr[i] = (v4u){0u, 0u, 0u, 0u}; }
        }
        float kf[32]; float ss = 0.f;
#pragma unroll
        for (int i = 0; i < 4; ++i)
#pragma unroll
            for (int j = 0; j < 4; ++j) { const unsigned w = kr[i][j]; kf[8 * i + 2 * j] = bflo(w); kf[8 * i + 2 * j + 1] = bfhi(w); }
#pragma unroll
        for (int i = 0; i < 32; ++i) ss += kf[i] * kf[i];
        ss += __shfl_xor(ss, 1);
        const float sc = 1.0f / sqrtf(ss * (1.0f / 64.f) + EPS);
#pragma unroll
        for (int i = 0; i < 32; ++i) kf[i] = kf[i] * sc * gk[32 * half + i];
#pragma unroll
        for (int i = 0; i < 4; ++i) { v4u o; o.x = pk2(kf[8 * i], kf[8 * i + 1]); o.y = pk2(kf[8 * i + 2], kf[8 * i + 3]); o.z = pk2(kf[8 * i + 4], kf[8 * i + 5]); o.w = pk2(kf[8 * i + 6], kf[8 * i + 7]);
            *(LAS v4u*)(Kl + key * 72 + 32 * half + 8 * i) = o; }
        const int pos = (key & ~15) | swap23(key & 15);
#pragma unroll
        for (int i = 0; i < 4; ++i)
#pragma unroll
            for (int j = 0; j < 4; ++j) { const unsigned w = vr[i][j];
                VTl[(32 * half + 8 * i + 2 * j) * 264 + pos] = (bf16)(w & 0xffffu); VTl[(32 * half + 8 * i + 2 * j + 1) * 264 + pos] = (bf16)(w >> 16); }
    }
    __syncthreads();
    const int r32 = lane & 31, hi = lane >> 5, qh = kh * 8 + wave;
    const float sink2 = sinks[qh] * LOG2E;
    float gqv[4][8];
#pragma unroll
    for (int ks = 0; ks < 4; ++ks)
#pragma unroll
        for (int j = 0; j < 8; ++j) gqv[ks][j] = gq[16 * ks + 8 * hi + j];
#pragma unroll 1
    for (int qb = 0; qb < 4; ++qb) {
        const size_t row = (size_t)128 * nb + 32 * qb + r32;
        const bf16* qp = Q + row * DM + qh * 64 + 8 * hi;
        float qf[4][8]; float ss = 0.f;
#pragma unroll
        for (int ks = 0; ks < 4; ++ks) { const v4u w = *(const v4u*)(qp + 16 * ks);
#pragma unroll
            for (int j = 0; j < 4; ++j) { qf[ks][2 * j] = bflo(w[j]); qf[ks][2 * j + 1] = bfhi(w[j]); } }
#pragma unroll
        for (int ks = 0; ks < 4; ++ks)
#pragma unroll
            for (int j = 0; j < 8; ++j) ss += qf[ks][j] * qf[ks][j];
        ss += __shfl_xor(ss, 32);
        const float rs = (1.0f / sqrtf(ss * (1.0f / 64.f) + EPS)) * 0.125f * LOG2E;
        bf16x8 qfr[4];
#pragma unroll
        for (int ks = 0; ks < 4; ++ks) qfr[ks] = pack8(qf[ks][0] * rs * gqv[ks][0], qf[ks][1] * rs * gqv[ks][1], qf[ks][2] * rs * gqv[ks][2], qf[ks][3] * rs * gqv[ks][3],
                                                        qf[ks][4] * rs * gqv[ks][4], qf[ks][5] * rs * gqv[ks][5], qf[ks][6] * rs * gqv[ks][6], qf[ks][7] * rs * gqv[ks][7]);
        f32x16 sc[5];
#pragma unroll
        for (int t = 0; t < 5; ++t) {
#pragma unroll
            for (int r = 0; r < 16; ++r) sc[t][r] = 0.f;
#pragma unroll
            for (int ks = 0; ks < 4; ++ks) { const bf16x8 kfr = *(const LAS bf16x8*)(Kl + (32 * (qb + t) + r32) * 72 + 16 * ks + 8 * hi); sc[t] = MFMA32(kfr, qfr[ks], sc[t]); }
        }
        const int qi = 32 * qb + r32; float m = sink2;
#pragma unroll
        for (int t = 0; t < 5; ++t)
#pragma unroll
            for (int r = 0; r < 16; ++r) { const int kj = 32 * (qb + t) + crow(r, hi); const int rel = qi + 128 - kj;
                const bool valid = (rel >= 0) && (rel < 128) && (nb > 0 || kj >= 128);
                sc[t][r] = valid ? sc[t][r] : -INFINITY; m = fmaxf(m, sc[t][r]); }
        m = fmaxf(m, __shfl_xor(m, 32));
        float l = 0.f;
#pragma unroll
        for (int t = 0; t < 5; ++t)
#pragma unroll
            for (int r = 0; r < 16; ++r) { const float pe = __builtin_amdgcn_exp2f(sc[t][r] - m); sc[t][r] = pe; l += pe; }
        l += __shfl_xor(l, 32); l += __builtin_amdgcn_exp2f(sink2 - m);
        f32x16 ot0, ot1;
#pragma unroll
        for (int r = 0; r < 16; ++r) { ot0[r] = 0.f; ot1[r] = 0.f; }
#pragma unroll
        for (int t = 0; t < 5; ++t)
#pragma unroll
            for (int s = 0; s < 2; ++s) {
                const bf16x8 pf = pack8(sc[t][8 * s + 0], sc[t][8 * s + 1], sc[t][8 * s + 2], sc[t][8 * s + 3], sc[t][8 * s + 4], sc[t][8 * s + 5], sc[t][8 * s + 6], sc[t][8 * s + 7]);
                const LAS bf16* vp = VTl + r32 * 264 + 32 * (qb + t) + 16 * s + 8 * hi;
                const bf16x8 v0 = *(const LAS bf16x8*)vp; const bf16x8 v1 = *(const LAS bf16x8*)(vp + 32 * 264);
                ot0 = MFMA32(v0, pf, ot0); ot1 = MFMA32(v1, pf, ot1);
            }
        const float inv = 1.0f / l;
        bf16* orow = O + row * DM + qh * 64 + 4 * hi;
#pragma unroll
        for (int rg = 0; rg < 4; ++rg) {
            v2u w0; w0.x = pk2(ot0[4 * rg] * inv, ot0[4 * rg + 1] * inv); w0.y = pk2(ot0[4 * rg + 2] * inv, ot0[4 * rg + 3] * inv); *(v2u*)(orow + 8 * rg) = w0;
            v2u w1; w1.x = pk2(ot1[4 * rg] * inv, ot1[4 * rg + 1] * inv); w1.y = pk2(ot1[4 * rg + 2] * inv, ot1[4 * rg + 3] * inv); *(v2u*)(orow + 32 + 8 * rg) = w1;
        }
    }
    __syncthreads();
}

__global__ void __launch_bounds__(NTHR, 2) yoco_fwd(Params p) {
    __shared__ __attribute__((aligned(16))) unsigned char lds_raw[LDS_BYTES];
    LAS unsigned char* lds = (LAS unsigned char*)lds_raw;
    cg::grid_group grid = cg::this_grid();
#ifndef REP_GLA
#define REP_GLA 1
#endif
#ifndef REP_CONV
#define REP_CONV 1
#endif
#ifndef EXTRA_SYNC
#define EXTRA_SYNC 0
#endif
#ifndef REP_NORM
#define REP_NORM 1
#endif
#ifndef CUT
#define CUT 1000
#endif
#define PHC() do { if (phc++ >= CUT) return; } while (0)
#define PWS() Params q = p; int bxq = blockIdx.x; asm volatile("" : "+s"(q.ws), "+s"(q.out), "+s"(bxq))
#define TIDS() int tid = threadIdx.x; asm volatile("" : "+v"(tid)); const int lane = tid & 63, wave = __builtin_amdgcn_readfirstlane(tid >> 6); const int gw = vcu * NWAVES + wave
    const int G = gridDim.x, bx = blockIdx.x; int phc = 0;
    volatile LAS unsigned* bst = (volatile LAS unsigned*)(lds + LDS_BYTES - 64);
    if (threadIdx.x < 2) bst[threadIdx.x] = 0u;
    __syncthreads();
    const XcdBarrier xbar = xcd_barrier_post((unsigned*)p.ws + 1024, bst);
#define GSYNC() xcd_barrier(xbar)
    const int vcu = (G % 8 == 0) ? (bx % 8) * (G / 8) + bx / 8 : bx;
    const int NGW = G * NWAVES;
    { PHC(); PWS(); TIDS(); convert_phase(q, lds, gw, NGW, wave, lane); }
    __syncthreads();
    { PHC(); PWS(); TIDS(); norm_phase<true, false, false>(q.in[0], nullptr, ((bf16*)(q.ws + WS_UN)), q.in[1], ((bf16*)(q.ws + WS_XN)), q.in[5], ((float*)(q.ws + WS_GLR)), nullptr, nullptr, lds, gw, NGW, tid, lane); }
    GSYNC();
    if (p.ws == nullptr) grid.sync();
#pragma unroll 1
    for (int layer = 0; layer < 4; ++layer) {

        if (layer < 2) {
            if (layer == 1) {
                { PHC(); PWS(); TIDS(); norm_phase<true, false, true>(nullptr, ((const bf16*)(q.ws + WS_UN)), nullptr, q.in[1] + layer * DM, ((bf16*)(q.ws + WS_XN)), q.in[5] + (size_t)layer * DM * GIN, ((float*)(q.ws + WS_GLR)), nullptr, nullptr, lds, gw, NGW, tid, lane); }
                GSYNC();
            }
            { PHC(); PWS(); pg8::Gemm g{((bf16*)(q.ws + WS_XN)), (const bf16*)(q.ws + WS_WINT) + (size_t)layer * NPROJ * DM, SEQ, NPROJ, DM}; pg8::StaticOrder S; S.init(SEQ, NPROJ, G, bxq);
              pg8::EpiBf16<0, false> E{(bf16*)(q.ws + WS_PROJ), NPROJ, nullptr};
              pg8::gemm_phase<pg8::EpiBf16<0, false>, pg8::StaticOrder, true, true>(lds, g, S, E); }
            GSYNC();
            { PHC(); PWS(); TIDS(); (void)gw; for (int u = vcu; u < 512; u += G) gla_prep_unit(q, layer, u >> 2, u & 3, lds, tid, wave, lane); }
            GSYNC();
            { PHC(); PWS(); TIDS(); (void)gw; for (int u = vcu; u < 240; u += G) gla_s1_unit(q, u >> 4, (u >> 2) & 3, u & 3, lds, tid, wave, lane); }
            GSYNC();
            { PHC(); PWS(); TIDS(); (void)gw; (void)lane; for (int gt = bxq * NTHR + tid; gt < 131072; gt += G * NTHR) gla_s2_phase(q, gt); }
            GSYNC();
            { PHC(); PWS(); TIDS(); (void)gw; for (int u = vcu; u < 256; u += G) gla_s3_unit(q, u >> 4, (u >> 2) & 3, u & 3, lds, tid, wave, lane); }
            GSYNC();
            { PHC(); PWS(); TIDS(); gla_post_phase(q, layer, gw, NGW, lane); }
            GSYNC();
            { PHC(); PWS(); pg8::Gemm g{(const bf16*)(q.ws + WS_Y), (const bf16*)(q.ws + WS_WOAT) + (size_t)layer * DM * DM, SEQ, DM, DM}; pg8::StaticOrder S; S.init(SEQ, DM, G, bxq);
              pg8::EpiRes<false> E{((bf16*)(q.ws + WS_UN)), nullptr, DM, ((float*)(q.ws + 613 * MiB)), nullptr};
              pg8::gemm_phase<pg8::EpiRes<false>, pg8::StaticOrder, true, true>(lds, g, S, E); }
            GSYNC();
        } else {
            const int lj = layer - 2;
            { PHC(); PWS(); pg8::Gemm g{((bf16*)(q.ws + WS_UN)), (const bf16*)(q.ws + WS_WQT) + (size_t)lj * DM * DM, SEQ, DM, DM}; pg8::StaticOrder S; S.init(SEQ, DM, G, bxq);
              pg8::EpiBf16<0, false> E{(bf16*)(q.ws + WS_QB), DM, nullptr};
              pg8::gemm_phase<pg8::EpiBf16<0, false>, pg8::StaticOrder, true, true>(lds, g, S, E); }
            if (layer == 2) {
              PHC(); PWS(); pg8::Gemm g{((bf16*)(q.ws + WS_UN)), (const bf16*)(q.ws + WS_WKVT), SEQ, 512, DM}; pg8::StaticOrder S; S.init(SEQ, 512, G, bxq);
              pg8::EpiBf16<0, true> E{(bf16*)(q.ws + WS_KVB), 512, ((float*)(q.ws + 812 * MiB))};
              pg8::gemm_phase<pg8::EpiBf16<0, true>, pg8::StaticOrder, true, true>(lds, g, S, E); }
            GSYNC();
            { PHC(); PWS(); TIDS(); (void)gw; for (int u = vcu; u < 256; u += G) attn_unit(q, lj, u >> 2, u & 3, lds, tid, wave, lane); }
            GSYNC();
            { PHC(); PWS(); pg8::Gemm g{(const bf16*)(q.ws + WS_OB), (const bf16*)(q.ws + WS_WOBT) + (size_t)lj * DM * DM, SEQ, DM, DM}; pg8::StaticOrder S; S.init(SEQ, DM, G, bxq);
              pg8::EpiRes<false> E{((bf16*)(q.ws + WS_UN)), nullptr, DM, ((float*)(q.ws + 613 * MiB)), nullptr};
              pg8::gemm_phase<pg8::EpiRes<false>, pg8::StaticOrder, true, true>(lds, g, S, E); }
            GSYNC();
        }
        { PHC(); PWS(); pg8::Gemm g{((bf16*)(q.ws + WS_UN)), (const bf16*)(q.ws + WS_W1T) + (size_t)layer * FF * DM, SEQ, FF, DM}; pg8::StaticOrder S; S.init(SEQ, FF, G, bxq);
          pg8::EpiBf16<2, false> E{((bf16*)(q.ws + WS_HB)), FF, nullptr};
          pg8::gemm_phase<pg8::EpiBf16<2, false>, pg8::StaticOrder, true, true>(lds, g, S, E); }
        GSYNC();
        if (layer < 3) { PHC(); PWS(); pg8::Gemm g{((bf16*)(q.ws + WS_HB)), (const bf16*)(q.ws + WS_W2T) + (size_t)layer * DM * FF, SEQ, DM, FF}; pg8::StaticOrder S; S.init(SEQ, DM, G, bxq);
          pg8::EpiRes<false> E{((bf16*)(q.ws + WS_UN)), nullptr, DM, ((float*)(q.ws + 812 * MiB)), ((const float*)(q.ws + 613 * MiB))};
          pg8::gemm_phase<pg8::EpiRes<false>, pg8::StaticOrder, true, true>(lds, g, S, E); }
        else { PHC(); PWS(); pg8::Gemm g{((bf16*)(q.ws + WS_HB)), (const bf16*)(q.ws + WS_W2T) + (size_t)layer * DM * FF, SEQ, DM, FF}; pg8::StaticOrder S; S.init(SEQ, DM, G, bxq);
          pg8::EpiRes<true> E{((bf16*)(q.ws + WS_UN)), q.out, DM, nullptr, ((const float*)(q.ws + 613 * MiB))};
          pg8::gemm_phase<pg8::EpiRes<true>, pg8::StaticOrder, true, true>(lds, g, S, E); }
        GSYNC();
    }
}

extern "C" void kernel_launch(void* const* d_in, const int* in_sizes, int n_in, void* d_out, int out_size, void* d_ws, size_t ws_size, hipStream_t stream) {
    static int grid = 0;
    if (grid == 0) {
        if (n_in != 18 || out_size != SEQ * DM || ws_size < WS_END) { fprintf(stderr, "kernel_launch: unexpected shapes (n_in %d out %d ws %zu)\n", n_in, out_size, ws_size); grid = -1; return; }
        int dev = 0, cus = 0, per_cu = 0;
        hipGetDevice(&dev); hipDeviceGetAttribute(&cus, hipDeviceAttributeMultiprocessorCount, dev);
        hipOccupancyMaxActiveBlocksPerMultiprocessor(&per_cu, (const void*)yoco_fwd, NTHR, 0);
        (void)hipGetLastError();
        if (per_cu < 1) per_cu = 1;
        grid = cus;
        if (grid > 256) grid = 256;
    }
    if (grid < 0) return;
    if (hipMemsetAsync(d_ws, 0, 65536, stream) != hipSuccess) { fprintf(stderr, "kernel_launch: memset failed\n"); return; }
    Params p{};
    for (int i = 0; i < 18; ++i) p.in[i] = (const float*)d_in[i];
    p.out = (float*)d_out; p.ws = (unsigned char*)d_ws;
    void* args[] = {&p};
    hipError_t e = hipLaunchCooperativeKernel((const void*)yoco_fwd, dim3(grid), dim3(NTHR), args, 0, stream);
    if (e != hipSuccess) fprintf(stderr, "cooperative launch failed: %s (grid %d)\n", hipGetErrorString(e), grid);
}
```
